# Optimizing an MI355X kernel written in HIP

```python
import jax, jax.numpy as jnp
from jax import lax
import numpy as np

D_MODEL = 1024
BATCH = 8
SEQ = 4096
DEPTH = 4

MIX_WIDTH = D_MODEL
GLA_WIDTH = MIX_WIDTH // 2
CONV_WIDTH = MIX_WIDTH - GLA_WIDTH
GLA_HEADS = 4
GLA_DV = GLA_WIDTH // GLA_HEADS
GLA_DK = GLA_DV // 2
GLA_KEY_WIDTH = GLA_HEADS * GLA_DK
GATE_RANK = 16
GATE_TAU = 16.0
CHUNK = 64
CONV_GROUPS = 8
CONV_K = 3
D_FF = 2816
EPS = 1e-6

SPLIT_SIZES = (GLA_KEY_WIDTH,
               GLA_KEY_WIDTH,
               GLA_WIDTH,
               GLA_WIDTH,
               GATE_RANK,
               CONV_WIDTH,
               CONV_WIDTH,
               CONV_WIDTH)
SPLIT_POINTS = tuple(int(v) for v in np.cumsum(SPLIT_SIZES)[:-1])
PROJ_WIDTH = int(sum(SPLIT_SIZES))

kernel_name = "hymba_style_gla_shortconv_macaron"


def rmsnorm(x, g):
    xf = x.astype(jnp.float32)
    y = xf * lax.rsqrt(jnp.mean(xf * xf, axis=-1, keepdims=True) + EPS)
    return (y * g.astype(jnp.float32)).astype(x.dtype)


def swiglu(x, w_gate, w_up, w_down):
    return (jax.nn.silu(x @ w_gate) * (x @ w_up)) @ w_down


def gla_chunked(q, k, v, logg):
    b_, t_, h_, dk = q.shape
    dv = v.shape[-1]
    n = t_ // CHUNK

    def to_chunks(a):
        return a.reshape(b_, n, CHUNK, h_, a.shape[-1]).transpose(1, 0, 3, 2, 4)

    qc, kc, vc, gc = to_chunks(q), to_chunks(k), to_chunks(v), to_chunks(logg)
    causal = jnp.tril(jnp.ones((CHUNK, CHUNK), dtype=bool))[None, None, :, :, None]

    def step(state, inp):
        qi, ki, vi, gi = inp
        bcum = jnp.cumsum(gi, axis=2)
        inter = jnp.einsum('bhck,bhkv->bhcv', qi * jnp.exp(bcum), state)
        diff = bcum[:, :, :, None, :] - bcum[:, :, None, :, :]
        decay = jnp.exp(jnp.where(causal, diff, -jnp.inf))
        scores = jnp.einsum('bhik,bhjk,bhijk->bhij', qi, ki, decay)
        out = inter + jnp.einsum('bhij,bhjv->bhiv', scores, vi)
        b_last = bcum[:, :, -1:, :]
        state = (state * jnp.exp(b_last[:, :, 0, :])[..., None]
                 + jnp.einsum('bhck,bhcv->bhkv', ki * jnp.exp(b_last - bcum), vi))
        return state, out

    s0 = jnp.zeros((b_, h_, dk, dv), jnp.float32)
    _, outs = lax.scan(step, s0, (qc, kc, vc, gc))
    return outs.transpose(1, 0, 3, 2, 4).reshape(b_, t_, h_, dv)


def causal_dwconv(u, w):
    c = u.shape[-1]
    return lax.conv_general_dilated(
        u, w.astype(u.dtype)[:, None, :], window_strides=(1,),
        padding=[(CONV_K - 1, 0)],
        dimension_numbers=('NWC', 'WIO', 'NWC'),
        feature_group_count=c)


def hybrid_mixer(h, w_in, w_a2, b_a, gla_out_norm, conv_w, w_out):
    b_, t_, _ = h.shape
    proj = h @ w_in
    q, k, v, g, a_lr, u, gate_b, gate_c = jnp.split(proj, SPLIT_POINTS, axis=-1)

    logg = jax.nn.log_sigmoid((a_lr @ w_a2 + b_a).astype(jnp.float32)) / GATE_TAU
    heads = lambda a, d: a.astype(jnp.float32).reshape(b_, t_, GLA_HEADS, d)
    o = gla_chunked(heads(q, GLA_DK) * (GLA_DK ** -0.5), heads(k, GLA_DK),
                    heads(v, GLA_DV), logg.reshape(b_, t_, GLA_HEADS, GLA_DK))
    o = o * lax.rsqrt(jnp.mean(o * o, axis=-1, keepdims=True) + EPS)
    o = (o * gla_out_norm.astype(jnp.float32)).reshape(b_, t_, GLA_WIDTH)
    o = o.astype(h.dtype) * jax.nn.silu(g)

    z = gate_b * causal_dwconv(gate_c * u, conv_w)

    return jnp.concatenate([o, z], axis=-1) @ w_out


def setup_inputs(seed: int = 0) -> dict:
    key = jax.random.key(seed)
    ks = jax.random.split(key, 20)
    f32 = jnp.float32

    def nrm(k, shape, fan_in):
        return jax.random.normal(k, shape, f32) * (fan_in ** -0.5)

    def gain(k, shape):
        return 1.0 + 0.02 * jax.random.normal(k, shape, f32)

    return {
        "x": jax.random.normal(ks[0], (BATCH, SEQ, D_MODEL), f32),
        "ffn1_norm": gain(ks[1], (DEPTH, D_MODEL)),
        "ffn1_w_gate": nrm(ks[2], (DEPTH, D_MODEL, D_FF), D_MODEL),
        "ffn1_w_up": nrm(ks[3], (DEPTH, D_MODEL, D_FF), D_MODEL),
        "ffn1_w_down": nrm(ks[4], (DEPTH, D_FF, D_MODEL), D_FF),
        "mix_norm": gain(ks[5], (DEPTH, D_MODEL)),
        "w_in": nrm(ks[6], (DEPTH, D_MODEL, PROJ_WIDTH), D_MODEL),
        "w_a2": nrm(ks[7], (DEPTH, GATE_RANK, GLA_KEY_WIDTH), GATE_RANK),
        "b_a": 0.01 * jax.random.normal(ks[8], (DEPTH, GLA_KEY_WIDTH), f32),
        "gla_out_norm": gain(ks[9], (DEPTH, GLA_DV)),
        "conv_w": nrm(ks[10], (DEPTH, CONV_K, CONV_WIDTH), CONV_K),
        "w_out": nrm(ks[11], (DEPTH, MIX_WIDTH, D_MODEL), MIX_WIDTH),
        "ffn2_norm": gain(ks[12], (DEPTH, D_MODEL)),
        "ffn2_w_gate": nrm(ks[13], (DEPTH, D_MODEL, D_FF), D_MODEL),
        "ffn2_w_up": nrm(ks[14], (DEPTH, D_MODEL, D_FF), D_MODEL),
        "ffn2_w_down": nrm(ks[15], (DEPTH, D_FF, D_MODEL), D_FF),
        "final_norm": gain(ks[16], (D_MODEL,)),
    }


def reference(x, ffn1_norm, ffn1_w_gate, ffn1_w_up, ffn1_w_down, mix_norm,
              w_in, w_a2, b_a, gla_out_norm, conv_w, w_out, ffn2_norm,
              ffn2_w_gate, ffn2_w_up, ffn2_w_down, final_norm):
    for l in range(DEPTH):
        x = x + 0.5 * swiglu(rmsnorm(x, ffn1_norm[l]),
                             ffn1_w_gate[l], ffn1_w_up[l], ffn1_w_down[l])
        x = x + hybrid_mixer(rmsnorm(x, mix_norm[l]), w_in[l], w_a2[l], b_a[l],
                             gla_out_norm[l], conv_w[l], w_out[l])
        x = x + 0.5 * swiglu(rmsnorm(x, ffn2_norm[l]),
                             ffn2_w_gate[l], ffn2_w_up[l], ffn2_w_down[l])
    return rmsnorm(x, final_norm)
```

```cpp
#include <hip/hip_runtime.h>
#include <cstdio>
#include <cstdint>
#ifndef MK_N_LAUNCHES
#define MK_N_LAUNCHES 34
#endif
namespace pg8 {
#define PG8_LAS __attribute__((address_space(3)))
typedef unsigned short bf16_t;
typedef short bf16x8 __attribute__((ext_vector_type(8)));
typedef float f32x4 __attribute__((ext_vector_type(4)));
typedef unsigned u32x4 __attribute__((ext_vector_type(4)));
constexpr int BM = 256, BK = 64, HALF = 128, HTB = HALF * BK * 2  , STAGE_BYTES = 8 * HTB, NXCD = 8, WGM = 8;

__host__ __device__ __forceinline__ int lds_byte(int r, int c) { const int st = (r >> 4) * 2 + (c >> 5), rr = r & 15, cc = c & 31, ob = rr * 64 + cc * 2; return st * 1024 + (ob ^ (((ob >> 9) & 1) << 5)); }
__host__ __device__ __forceinline__ void stage_rc(int b, int& R, int& C) { const int st = b / 1024, sb = b % 1024, swz = sb ^ (((sb >> 9) & 1) << 5); R = (st >> 1) * 16 + swz / 64; C = (st & 1) * 32 + (swz % 64) / 2; }
__host__ __device__ __forceinline__ int perm32(int rho) { const int n = rho >> 4, i = rho & 15; return 8 * (i >> 2) + 4 * n + (i & 3); }

struct Unit { int pm, pn; };
struct Gemm { const bf16_t* A; const bf16_t* Bt; int M, N, K; };

struct StaticOrder {
    int nM, nN, nwg, G, c;
    __host__ __device__ void init(int M, int N, int G_, int c_) { nM = M / BM; nN = N / BM; nwg = nM * nN; G = G_; c = c_; }
    __host__ __device__ bool next(int i, Unit& u) const {
        const long L = (long)i * G + c; if (L >= nwg) return false;
        int wgid = (int)L; { const int q = nwg / NXCD, r = nwg % NXCD, xcd = wgid % NXCD, off = wgid / NXCD; wgid = (xcd < r ? xcd * (q + 1) : r * (q + 1) + (xcd - r) * q) + off; }
        const int nig = WGM * nN, gid = wgid / nig, fm = gid * WGM, gsz = (nM - fm) < WGM ? (nM - fm) : WGM;
        u.pm = fm + ((wgid % nig) % gsz); u.pn = (wgid % nig) / gsz; return true;
    }
    __device__ __forceinline__ void a_ready(const Unit&) const {}
    __device__ __forceinline__ void done(const Unit&) const {}
};

typedef float f32x2 __attribute__((ext_vector_type(2)));
typedef __bf16 bf16x2v __attribute__((ext_vector_type(2)));
constexpr float RMS_EPS = 1e-6f;
__device__ __forceinline__ unsigned pk_bf16(float lo, float hi) { const f32x2 v = {lo, hi}; return __builtin_bit_cast(unsigned, __builtin_convertvector(v, bf16x2v)); }
__device__ __forceinline__ float bf_lo(unsigned w) { return __builtin_bit_cast(float, w << 16); }
__device__ __forceinline__ float bf_hi(unsigned w) { return __builtin_bit_cast(float, w & 0xffff0000u); }
__device__ __forceinline__ float silu_f(float x) { return x * __builtin_amdgcn_rcpf(1.0f + __builtin_amdgcn_exp2f(-1.44269504089f * x)); }
constexpr float SSQ_SCALE = 1048576.0f;
__device__ __forceinline__ unsigned long long ssq_fix(float s) { return (unsigned long long)(s * SSQ_SCALE + 0.5f); }
__device__ __forceinline__ float row_rstd(const unsigned long long* ssq, int r) { return __builtin_amdgcn_rsqf((float)ssq[r] * (1.0f / (1024.0f * SSQ_SCALE)) + RMS_EPS); }

struct EpiSwiGLU {
    static constexpr bool PERM = true, AFTER_DRAIN = false;
    bf16_t* Hb; const unsigned long long* ssq; int ldh;
    __device__ __forceinline__ void operator()(const f32x4 (&acc)[2][2][4][2], const Unit& u, int wr, int wc, int fr, int fq) const {
        const int row0 = u.pm * BM + wr * 64 + fr, col0 = u.pn * HALF + wc * 32 + 8 * fq;
#pragma unroll
        for (int ai = 0; ai < 2; ++ai)
#pragma unroll
            for (int m = 0; m < 4; ++m) {
                const int r = row0 + ai * HALF + m * 16;
                const float rs = row_rstd(ssq, r);
                float hv[8];
#pragma unroll
                for (int n = 0; n < 2; ++n)
#pragma unroll
                    for (int j = 0; j < 4; ++j) { const float g = acc[ai][0][m][n][j] * rs, up = acc[ai][1][m][n][j] * rs; hv[4 * n + j] = silu_f(g) * up; }
                u32x4 w; w.x = pk_bf16(hv[0], hv[1]); w.y = pk_bf16(hv[2], hv[3]); w.z = pk_bf16(hv[4], hv[5]); w.w = pk_bf16(hv[6], hv[7]);
                *(u32x4*)(Hb + (size_t)r * ldh + col0) = w;
            }
    }
};
struct EpiResidual {
    static constexpr bool PERM = true, AFTER_DRAIN = false;
    bf16_t* X; unsigned long long* ssq_out;
    __device__ __forceinline__ void operator()(const f32x4 (&acc)[2][2][4][2], const Unit& u, int wr, int wc, int fr, int fq) const {
        const int row0 = u.pm * BM + wr * 64 + fr, col0 = u.pn * BM + wc * 32 + 8 * fq;
#pragma unroll
        for (int ai = 0; ai < 2; ++ai)
#pragma unroll
            for (int m = 0; m < 4; ++m) {
                const int r = row0 + ai * HALF + m * 16;
                bf16_t* rowp = X + (size_t)r * 1024 + col0;
                float s = 0.f;
#pragma unroll
                for (int bj = 0; bj < 2; ++bj) {
                    const u32x4 o = *(const u32x4*)(rowp + bj * HALF);
                    const f32x4 a0 = acc[ai][bj][m][0], a1 = acc[ai][bj][m][1];
                    const float v0 = bf_lo(o.x) + a0[0], v1 = bf_hi(o.x) + a0[1], v2 = bf_lo(o.y) + a0[2], v3 = bf_hi(o.y) + a0[3];
                    const float v4 = bf_lo(o.z) + a1[0], v5 = bf_hi(o.z) + a1[1], v6 = bf_lo(o.w) + a1[2], v7 = bf_hi(o.w) + a1[3];
                    s += (v0 * v0 + v1 * v1) + (v2 * v2 + v3 * v3) + (v4 * v4 + v5 * v5) + (v6 * v6 + v7 * v7);
                    u32x4 w; w.x = pk_bf16(v0, v1); w.y = pk_bf16(v2, v3); w.z = pk_bf16(v4, v5); w.w = pk_bf16(v6, v7);
                    *(u32x4*)(rowp + bj * HALF) = w;
                }
                s += __shfl_xor(s, 16); s += __shfl_xor(s, 32);
                if (fq == 0) (void)__hip_atomic_fetch_add(ssq_out + r, ssq_fix(s), __ATOMIC_RELAXED, __HIP_MEMORY_SCOPE_AGENT);
            }
    }
};
struct EpiInProj {
    static constexpr bool PERM = true, AFTER_DRAIN = false;
    bf16_t *Q, *K, *V, *SG, *CU, *GB, *ALR; const unsigned long long* ssq;
    __device__ __forceinline__ void operator()(const f32x4 (&acc)[2][2][4][2], const Unit& u, int wr, int wc, int fr, int fq) const {
        const int row0 = u.pm * BM + wr * 64 + fr, pn = u.pn, cw = wc * 32 + 8 * fq;
        if (pn >= 6 && pn <= 9) {
#pragma unroll
            for (int ai = 0; ai < 2; ++ai)
#pragma unroll
                for (int m = 0; m < 4; ++m) {
                    const int r = row0 + ai * HALF + m * 16; const float rs = row_rstd(ssq, r), rs2 = rs * rs;
                    float hv[8];
#pragma unroll
                    for (int n = 0; n < 2; ++n)
#pragma unroll
                        for (int j = 0; j < 4; ++j) hv[4 * n + j] = (acc[ai][0][m][n][j] * acc[ai][1][m][n][j]) * rs2;
                    u32x4 w; w.x = pk_bf16(hv[0], hv[1]); w.y = pk_bf16(hv[2], hv[3]); w.z = pk_bf16(hv[4], hv[5]); w.w = pk_bf16(hv[6], hv[7]);
                    *(u32x4*)(CU + (size_t)r * 512 + (pn - 6) * HALF + cw) = w;
                }
        } else if (pn == 12) {
            if (wc == 0 && fq < 2) {
#pragma unroll
                for (int ai = 0; ai < 2; ++ai)
#pragma unroll
                    for (int m = 0; m < 4; ++m) {
                        const int r = row0 + ai * HALF + m * 16; const float rs = row_rstd(ssq, r);
                        const f32x4 a0 = acc[ai][0][m][0] * rs, a1 = acc[ai][0][m][1] * rs;
                        u32x4 w; w.x = pk_bf16(a0[0], a0[1]); w.y = pk_bf16(a0[2], a0[3]); w.z = pk_bf16(a1[0], a1[1]); w.w = pk_bf16(a1[2], a1[3]);
                        *(u32x4*)(ALR + (size_t)r * 16 + 8 * fq) = w;
                    }
            }
        } else {
            bf16_t* base; int ldc, coff; bool act = false;
            if (pn == 0) { base = Q; ldc = 256; coff = 0; }
            else if (pn == 1) { base = K; ldc = 256; coff = 0; }
            else if (pn <= 3) { base = V; ldc = 512; coff = (pn - 2) * BM; }
            else if (pn <= 5) { base = SG; ldc = 512; coff = (pn - 4) * BM; act = true; }
            else { base = GB; ldc = 512; coff = (pn - 10) * BM; }
#pragma unroll
            for (int ai = 0; ai < 2; ++ai)
#pragma unroll
                for (int m = 0; m < 4; ++m) {
                    const int r = row0 + ai * HALF + m * 16; const float rs = row_rstd(ssq, r);
                    bf16_t* rowp = base + (size_t)r * ldc + coff + cw;
#pragma unroll
                    for (int bj = 0; bj < 2; ++bj) {
                        f32x4 a0 = acc[ai][bj][m][0] * rs, a1 = acc[ai][bj][m][1] * rs;
                        if (act) {
#pragma unroll
                            for (int j = 0; j < 4; ++j) { a0[j] = silu_f(a0[j]); a1[j] = silu_f(a1[j]); }
                        }
                        u32x4 w; w.x = pk_bf16(a0[0], a0[1]); w.y = pk_bf16(a0[2], a0[3]); w.z = pk_bf16(a1[0], a1[1]); w.w = pk_bf16(a1[2], a1[3]);
                        *(u32x4*)(rowp + bj * HALF) = w;
                    }
                }
        }
    }
};
template <class Epi, class Sched, bool ALIGN_EPI = false, bool SP2 = false>
__device__ __forceinline__ void gemm_phase(PG8_LAS unsigned char* lds, const Gemm g, const Sched& S, const Epi& E) {
    int tid_ = threadIdx.x; asm volatile("" : "+v"(tid_));
    const int tid = tid_, wid = __builtin_amdgcn_readfirstlane(tid >> 6), lane = tid & 63, wr = wid >> 2, wc = wid & 3, fr = lane & 15, fq = lane >> 4;
    const int K = g.K, nt = K / BK;
    unsigned voffA[2], voffB[2];
#pragma unroll
    for (int i = 0; i < 2; ++i) { int R, C; stage_rc(tid * 16 + i * 8192, R, C); const int Rb = Epi::PERM ? ((R & ~31) + perm32(R & 31)) : R;
        voffA[i] = (unsigned)(R * K + C) * 2u; voffB[i] = (unsigned)(Rb * K + C) * 2u; }
    const size_t kstep = (size_t)(BK * 2);
    const size_t hstep = (size_t)HALF * K * 2;
    const size_t tstep = 2 * hstep;
    const unsigned ldsw = (unsigned)wid * 1024u;
    const int aoff = lds_byte(wr * 64 + fr, fq * 8), boff = lds_byte(wc * 32 + fr, fq * 8);
#define PG8_SA(b, h) (((b) * 2 + (h)) * HTB)
#define PG8_SB(b, h) ((4 + (b) * 2 + (h)) * HTB)
#define PG8_STAGE(bufoff, gbase, voff) do { _Pragma("unroll") for (int _i = 0; _i < 2; ++_i) \
        __builtin_amdgcn_global_load_lds((const unsigned*)((const char*)(gbase) + (voff)[_i]), (PG8_LAS unsigned*)(lds + (bufoff) + ldsw + _i * 8192), 16, 0, 0); } while (0)
#define PG8_LDA(dst, b, h) do { _Pragma("unroll") for (int m = 0; m < 4; ++m) _Pragma("unroll") for (int k = 0; k < 2; ++k) dst[m][k] = *(const PG8_LAS bf16x8*)(lds + PG8_SA(b, h) + aoff + m * 2048 + k * 1024); } while (0)
#define PG8_LDB(dst, b, h) do { _Pragma("unroll") for (int n = 0; n < 2; ++n) _Pragma("unroll") for (int k = 0; k < 2; ++k) dst[n][k] = *(const PG8_LAS bf16x8*)(lds + PG8_SB(b, h) + boff + n * 2048 + k * 1024); } while (0)
#define PG8_MMA(ai, bj, At, Bt) do { __builtin_amdgcn_s_setprio(1); _Pragma("unroll") for (int m = 0; m < 4; ++m) _Pragma("unroll") for (int n = 0; n < 2; ++n) _Pragma("unroll") for (int k = 0; k < 2; ++k) \
        acc[ai][bj][m][n] = __builtin_amdgcn_mfma_f32_16x16x32_bf16(Bt[n][k], At[m][k], acc[ai][bj][m][n], 0, 0, 0); __builtin_amdgcn_s_setprio(0); } while (0)
#define PG8_WAIT_V(n) asm volatile("s_waitcnt vmcnt(" #n ")" ::: "memory")
#define PG8_WAIT_L(n) asm volatile("s_waitcnt lgkmcnt(" #n ")" ::: "memory")
#define PG8_BAR __builtin_amdgcn_s_barrier()
#define PG8_SCHED __builtin_amdgcn_sched_barrier(0)
    Unit cur, nxt; int ui = 0;
    if (!S.next(0, cur)) return;
    f32x4 acc[2][2][4][2];
#pragma unroll
    for (int a = 0; a < 2; ++a)
#pragma unroll
        for (int b = 0; b < 2; ++b)
#pragma unroll
            for (int m = 0; m < 4; ++m)
#pragma unroll
                for (int n = 0; n < 2; ++n) acc[a][b][m][n] = (f32x4){0.f, 0.f, 0.f, 0.f};
    bf16x8 At[4][2], B0[2][2], B1[2][2];
    const char* cA = (const char*)g.A + (size_t)cur.pm * tstep; const char* cB = (const char*)g.Bt + (size_t)cur.pn * tstep;
    S.a_ready(cur);
    if constexpr (SP2) {
        PG8_STAGE(PG8_SB(0, 0), cB, voffB); PG8_STAGE(PG8_SB(0, 1), cB + hstep, voffB); PG8_STAGE(PG8_SA(0, 0), cA, voffA); PG8_STAGE(PG8_SA(0, 1), cA + hstep, voffA);
        if (wr == 1) PG8_BAR;
        PG8_WAIT_V(2); PG8_BAR;
        PG8_STAGE(PG8_SB(1, 0), cB + kstep, voffB); PG8_STAGE(PG8_SA(1, 0), cA + kstep, voffA); PG8_STAGE(PG8_SB(1, 1), cB + hstep + kstep, voffB);
        PG8_WAIT_V(6); PG8_BAR;
    } else {
        PG8_STAGE(PG8_SB(0, 0), cB, voffB); PG8_STAGE(PG8_SA(0, 0), cA, voffA); PG8_STAGE(PG8_SB(0, 1), cB + hstep, voffB); PG8_STAGE(PG8_SA(0, 1), cA + hstep, voffA);
        if (wr == 1) PG8_BAR;
        PG8_WAIT_V(4); PG8_BAR;
        PG8_STAGE(PG8_SB(1, 0), cB + kstep, voffB); PG8_STAGE(PG8_SA(1, 0), cA + kstep, voffA); PG8_STAGE(PG8_SB(1, 1), cB + hstep + kstep, voffB);
        PG8_WAIT_V(6); PG8_BAR;
    }
    for (;;) {
        const bool has_next = S.next(ui + 1, nxt);
        const char* nA = has_next ? (const char*)g.A + (size_t)nxt.pm * tstep : cA; const char* nB = has_next ? (const char*)g.Bt + (size_t)nxt.pn * tstep : cB;
        for (int t = 0; t < nt; t += 2) {
            const bool last = (t == nt - 2);
            const char* a1 = cA + (size_t)(t + 1) * kstep;
            const char* a2 = last ? nA : cA + (size_t)(t + 2) * kstep; const char* b2 = last ? nB : cB + (size_t)(t + 2) * kstep;
            const char* a3 = a2 + kstep; const char* b3 = b2 + kstep;
            if (last && has_next) S.a_ready(nxt);
            if constexpr (SP2) {
            PG8_LDB(B0, 0, 0); PG8_LDB(B1, 0, 1); PG8_SCHED; PG8_LDA(At, 0, 0); PG8_STAGE(PG8_SA(1, 1), a1 + hstep, voffA);
            PG8_WAIT_V(8); PG8_WAIT_L(0); PG8_BAR; PG8_MMA(0, 0, At, B0); PG8_MMA(0, 1, At, B1); PG8_BAR; PG8_SCHED;
            PG8_LDA(At, 0, 1); PG8_STAGE(PG8_SB(0, 0), b2, voffB); PG8_STAGE(PG8_SB(0, 1), b2 + hstep, voffB); PG8_STAGE(PG8_SA(0, 0), a2, voffA);
            PG8_WAIT_V(8); PG8_WAIT_L(0); PG8_BAR; PG8_MMA(1, 0, At, B0); PG8_MMA(1, 1, At, B1); PG8_BAR; PG8_SCHED;
            PG8_LDB(B0, 1, 0); PG8_LDB(B1, 1, 1); PG8_SCHED; PG8_LDA(At, 1, 0); PG8_STAGE(PG8_SA(0, 1), a2 + hstep, voffA);
            PG8_WAIT_V(8); PG8_WAIT_L(0); PG8_BAR; PG8_MMA(0, 0, At, B0); PG8_MMA(0, 1, At, B1); PG8_BAR; PG8_SCHED;
            PG8_LDA(At, 1, 1); PG8_STAGE(PG8_SB(1, 0), b3, voffB); PG8_STAGE(PG8_SB(1, 1), b3 + hstep, voffB); PG8_STAGE(PG8_SA(1, 0), a3, voffA);
            PG8_WAIT_V(8); PG8_WAIT_L(0); PG8_BAR; PG8_MMA(1, 0, At, B0); PG8_MMA(1, 1, At, B1); PG8_BAR; PG8_SCHED;
            } else {
            PG8_LDB(B0, 0, 0); PG8_SCHED; PG8_LDA(At, 0, 0); PG8_STAGE(PG8_SA(1, 1), a1 + hstep, voffA);
            PG8_WAIT_L(8); PG8_BAR; PG8_WAIT_L(0); PG8_MMA(0, 0, At, B0); PG8_BAR; PG8_SCHED;
            PG8_LDB(B1, 0, 1); PG8_STAGE(PG8_SB(0, 0), b2, voffB);
            PG8_BAR; PG8_WAIT_L(0); PG8_MMA(0, 1, At, B1); PG8_BAR;
            PG8_LDA(At, 0, 1); PG8_STAGE(PG8_SA(0, 0), a2, voffA);
            PG8_BAR; PG8_WAIT_L(0); PG8_MMA(1, 0, At, B0); PG8_BAR; PG8_SCHED;
            PG8_STAGE(PG8_SB(0, 1), b2 + hstep, voffB);
            PG8_WAIT_V(6); PG8_BAR; PG8_MMA(1, 1, At, B1); PG8_BAR;
            PG8_LDB(B0, 1, 0); PG8_SCHED; PG8_LDA(At, 1, 0); PG8_STAGE(PG8_SA(0, 1), a2 + hstep, voffA);
            PG8_WAIT_L(8); PG8_BAR; PG8_WAIT_L(0); PG8_MMA(0, 0, At, B0); PG8_BAR; PG8_SCHED;
            PG8_LDB(B1, 1, 1); PG8_STAGE(PG8_SB(1, 0), b3, voffB);
            PG8_BAR; PG8_WAIT_L(0); PG8_MMA(0, 1, At, B1); PG8_BAR;
            PG8_LDA(At, 1, 1); PG8_STAGE(PG8_SA(1, 0), a3, voffA);
            PG8_BAR; PG8_WAIT_L(0); PG8_MMA(1, 0, At, B0); PG8_BAR; PG8_SCHED;
            PG8_STAGE(PG8_SB(1, 1), b3 + hstep, voffB);
            PG8_WAIT_V(6); PG8_BAR; PG8_MMA(1, 1, At, B1); PG8_BAR;
            }
        }
        if constexpr (ALIGN_EPI) { if (wr == 0) PG8_BAR; }
        if constexpr (!Epi::AFTER_DRAIN) { E(acc, cur, wr, wc, fr, fq); S.done(cur); }
        if (!has_next) break;
#pragma unroll
        for (int a = 0; a < 2; ++a)
#pragma unroll
            for (int b = 0; b < 2; ++b)
#pragma unroll
                for (int m = 0; m < 4; ++m)
#pragma unroll
                    for (int n = 0; n < 2; ++n) acc[a][b][m][n] = (f32x4){0.f, 0.f, 0.f, 0.f};
        cur = nxt; cA = nA; cB = nB; ++ui;
        if constexpr (ALIGN_EPI) { if (wr == 1) PG8_BAR; }
    }
    PG8_WAIT_V(0);
    if constexpr (!ALIGN_EPI) { if (wr == 0) PG8_BAR; }
    PG8_BAR;
    if constexpr (Epi::AFTER_DRAIN) { E.fused(acc, cur, wr, wc, fr, fq, lds, wid, lane); S.done(cur); }
#undef PG8_SA
#undef PG8_SB
#undef PG8_STAGE
#undef PG8_LDA
#undef PG8_LDB
#undef PG8_MMA
#undef PG8_WAIT_V
#undef PG8_WAIT_L
#undef PG8_BAR
#undef PG8_SCHED
}
}
#define GAS __attribute__((address_space(1)))
#define LAS __attribute__((address_space(3)))
typedef unsigned short bf16;
typedef unsigned v4u __attribute__((ext_vector_type(4)));
typedef float f32x4 __attribute__((ext_vector_type(4)));
typedef short bf16x8 __attribute__((ext_vector_type(8)));
typedef GAS unsigned gu32;
typedef GAS unsigned long long gu64;
#define RLX_AGENT __ATOMIC_RELAXED, __HIP_MEMORY_SCOPE_AGENT
#define LDS_WAIT() asm volatile("s_waitcnt lgkmcnt(0)" ::: "memory")
#define VM_WAIT() asm volatile("s_waitcnt vmcnt(0)" ::: "memory")
__device__ __forceinline__ unsigned long long rt() { return __builtin_amdgcn_s_memrealtime(); }
__device__ __forceinline__ unsigned f2bf(float f) { unsigned u = __builtin_bit_cast(unsigned, f); return (u + 0x7fffu + ((u >> 16) & 1u)) >> 16; }
__device__ __forceinline__ unsigned pk2(float lo, float hi) { return f2bf(lo) | (f2bf(hi) << 16); }

#define XB_TMO      128
#define XB_XCNT(j)  (256  + 64 * (j))
#define XB_XSUB(j)  (1280 + 64 * (j))
#define XB_XGEN(j)  (2304 + 64 * (j))
#define XB_TOP      3328
#define XB_TOPGEN   3392
#define XCD_BAR_WORDS 3456
#define XB_SPIN_CAP (1u << 18)

__device__ __forceinline__ unsigned xb_ld(unsigned* p)              { return __hip_atomic_load(p, __ATOMIC_RELAXED, __HIP_MEMORY_SCOPE_AGENT); }
__device__ __forceinline__ unsigned xb_add(unsigned* p, unsigned v) { return __hip_atomic_fetch_add(p, v, __ATOMIC_RELAXED, __HIP_MEMORY_SCOPE_AGENT); }
__device__ __forceinline__ unsigned xb_xcc_id() { return (unsigned)__builtin_amdgcn_s_getreg((3 << 11) | 20) & 0xFu; }
#define XB_SPIN(cond, bar) do { unsigned _sp = 0; while (cond) { __builtin_amdgcn_s_sleep(1); \
    if ((++_sp & 255u) == 0u) { if (xb_ld(&(bar)[XB_TMO])) break; if (_sp > XB_SPIN_CAP) { atomicAdd(&(bar)[XB_TMO], 1u); break; } } } } while (0)

struct XcdBarrier {
    unsigned* bar; unsigned x;
    volatile LAS unsigned* st;
};

__device__ __forceinline__ XcdBarrier xcd_barrier_post(unsigned* bar, volatile LAS unsigned* st) {
    XcdBarrier b; b.bar = bar; b.x = xb_xcc_id(); b.st = st;
    if (threadIdx.x == 0) (void)xb_add(&bar[XB_XCNT(b.x)], 1u);
    return b;
}
__device__ __forceinline__ void xcd_barrier_complete(unsigned* bar, unsigned x, unsigned& nloc, unsigned& nx) {
    const unsigned G = gridDim.x * gridDim.y * gridDim.z;
    unsigned sum, cnt, mine, sp = 0u;
    for (;;) {
        sum = 0u; cnt = 0u; mine = 0u;
#pragma unroll
        for (unsigned j = 0; j < 16; ++j) { const unsigned c = xb_ld(&bar[XB_XCNT(j)]); sum += c; cnt += (c > 0u) ? 1u : 0u; mine = (j == x) ? c : mine; }
        if (sum == G) break;
        __builtin_amdgcn_s_sleep(1);
        if ((++sp & 255u) == 0u) { if (xb_ld(&bar[XB_TMO])) break; if (sp > XB_SPIN_CAP) { atomicAdd(&bar[XB_TMO], 1u); break; } }
    }
    nloc = mine > 0u ? mine : 1u; nx = cnt > 0u ? cnt : 1u;
}

__device__ __forceinline__ void xcd_barrier(const XcdBarrier& b) {
    asm volatile("s_waitcnt vmcnt(0)" ::: "memory");
    __syncthreads();
    if (threadIdx.x == 0) {
        unsigned* bar = b.bar;
        __builtin_amdgcn_s_waitcnt(0);
        unsigned nloc = b.st[0], nx = b.st[1];
        if (nloc == 0u) { xcd_barrier_complete(bar, b.x, nloc, nx); b.st[0] = nloc; b.st[1] = nx; }
        const unsigned old = xb_add(&bar[XB_XSUB(b.x)], 1u);
        const unsigned gen = old / nloc;
        if (old + 1u == (gen + 1u) * nloc) {
            __builtin_amdgcn_fence(__ATOMIC_RELEASE, "agent");
            asm volatile("s_waitcnt vmcnt(0)" ::: "memory");
            const unsigned og = xb_add(&bar[XB_TOP], 1u);
            const unsigned tg = og / nx;
            if (og + 1u == (tg + 1u) * nx) xb_add(&bar[XB_TOPGEN], 1u);
            else XB_SPIN(xb_ld(&bar[XB_TOPGEN]) == tg, bar);
            __builtin_amdgcn_fence(__ATOMIC_ACQUIRE, "agent");
            xb_add(&bar[XB_XGEN(b.x)], 1u);
            asm volatile("s_waitcnt vmcnt(0)" ::: "memory");
        } else {
            XB_SPIN(xb_ld(&bar[XB_XGEN(b.x)]) == gen, bar);
            __builtin_amdgcn_fence(__ATOMIC_ACQUIRE, "agent");
            asm volatile("s_waitcnt vmcnt(0)" ::: "memory");
        }
    }
    __syncthreads();
}


constexpr int D = 1024, BATCH = 8, SEQ = 4096, M = BATCH * SEQ, DEPTH = 4, FF = 2816, NUP = 2 * FF, PROJ = 3088, NIN = 3328;
constexpr int NH = 4, DK = 64, DV = 128, RANK = 16, CHUNK = 64, SEGC = 8  , NSEG = SEQ / (CHUNK * SEGC)  , NUNIT = BATCH * NH * NSEG  ;
constexpr int NSLOT = 2 * DEPTH;
constexpr int NWAVES = 8, NTHR = NWAVES * 64;
enum { I_X = 0, I_F1N, I_F1G, I_F1U, I_F1D, I_MIXN, I_WIN, I_WA2, I_BA, I_GON, I_CONVW, I_WOUT, I_F2N, I_F2G, I_F2U, I_F2D, I_FINN, N_IN };
constexpr size_t MiB = 1u << 20;
constexpr size_t WS_CTL = 0, WS_SSQ = 1 * MiB, CTL_ZERO_BYTES = 5 * MiB;
constexpr size_t WS_WUP = 6 * MiB;
constexpr size_t WS_WDN = 94 * MiB;
constexpr size_t WS_WIN = 138 * MiB;
constexpr size_t WS_WOUT = 164 * MiB;
constexpr size_t WS_XB = 172 * MiB;
constexpr size_t WS_H = 236 * MiB;
constexpr size_t WS_Q = WS_H, WS_K = WS_Q + 16 * MiB, WS_V = WS_K + 16 * MiB, WS_SG = WS_V + 32 * MiB, WS_CU = WS_SG + 32 * MiB, WS_GB = WS_CU + 32 * MiB, WS_ALR = WS_GB + 32 * MiB;
constexpr size_t WS_Y = 412 * MiB;
constexpr size_t WS_SEGS = 476 * MiB;
constexpr size_t WS_SEGD = 484 * MiB;
constexpr size_t WS_END = 485 * MiB;
static_assert(WS_SSQ + (size_t)13 * M * 8 <= CTL_ZERO_BYTES && CTL_ZERO_BYTES <= WS_WUP, "ssq map");
static_assert(WS_ALR + (size_t)M * 16 * 2 <= WS_H + (size_t)M * FF * 2 && WS_H + (size_t)M * FF * 2 <= WS_Y, "d_ws map");
constexpr int CW_TMO = 0;
constexpr int CW_BAR = 4096;
constexpr int RING_OFF = 0, RING_BYTES = 131072;
constexpr int LDSCTL_OFF = RING_BYTES, MISC_OFF = LDSCTL_OFF + 320;
constexpr int LDS_BYTES = 147456;
constexpr int G_O = 0;
constexpr int G_QT = 33792, G_KT = G_QT + 9216, G_KH = G_KT + 9216, G_P = G_KH + 9216;
constexpr int G_VT = G_P + 9216, G_ST = G_VT + 18432;
constexpr int G_ALR = G_ST + 18432, G_W2T = G_ALR + 3072;
constexpr int G_GT = G_W2T + 3072, G_D = G_GT + 2048, G_END = G_D + 256;
static_assert(G_END <= RING_BYTES, "GLA LDS map");

typedef unsigned long long u64;
typedef float f32x16 __attribute__((ext_vector_type(16)));
typedef unsigned v2u __attribute__((ext_vector_type(2)));
using pg8::pk_bf16; using pg8::bf_lo; using pg8::bf_hi; using pg8::RMS_EPS;

struct Frame {
    LAS unsigned char* lds;
    volatile LAS unsigned* MISC;
    gu32* ctl;
    int tid, lane, wave, G;
    const float* const* in; float* out; unsigned char* ws;
};

__device__ __forceinline__ float wave_sum(float v) {
#pragma unroll
    for (int o = 1; o < 64; o <<= 1) v += __shfl_xor(v, o);
    return v;
}

__device__ __forceinline__ void tr_item(const float* src, int srcN, int k0, int scol0, int nvalid, bf16* dst, int dstK, int drow0, const float* gain, float scale, LAS float* scr, int lane) {
    const int n = lane & 31;
#pragma unroll 8
    for (int i = 0; i < 32; ++i) { const int kk = 2 * i + (lane >> 5);
        float v = 0.f; if (n < nvalid) { v = src[(size_t)(k0 + kk) * srcN + scol0 + n] * scale; if (gain) v *= gain[k0 + kk]; }
        scr[kk * 33 + n] = v; }
    LDS_WAIT(); asm volatile("" ::: "memory");
    const int c = lane & 7;
#pragma unroll
    for (int j = 0; j < 4; ++j) { const int nn = (lane >> 3) + 8 * j; const LAS float* s = scr + (8 * c) * 33 + nn;
        v4u o; o.x = pk_bf16(s[0 * 33], s[1 * 33]); o.y = pk_bf16(s[2 * 33], s[3 * 33]); o.z = pk_bf16(s[4 * 33], s[5 * 33]); o.w = pk_bf16(s[6 * 33], s[7 * 33]);
        *(GAS v4u*)(dst + (size_t)(drow0 + nn) * dstK + k0 + 8 * c) = o; }
    LDS_WAIT(); asm volatile("" ::: "memory");
}
__device__ __forceinline__ void p0_prologue(Frame& F) {
    LAS float* scr = (LAS float*)(F.lds + RING_OFF + F.wave * 16384);
    const int gw = blockIdx.x * NWAVES + F.wave, NGW = F.G * NWAVES, lane = F.lane;
    constexpr int I_UP = (D / 64) * (NUP / 32), I_DN = (FF / 64) * (D / 32), I_IN = (D / 64) * (NIN / 32), I_OUT = (D / 64) * (D / 32);
    constexpr int T_UP = NSLOT * I_UP, T_DN = NSLOT * I_DN, T_IN = DEPTH * I_IN, T_OUT = DEPTH * I_OUT, NITEMS = T_UP + T_DN + T_IN + T_OUT;
    for (int it = gw; it < NITEMS; it += NGW) {
        int r = it;
        if (r < T_UP) {
            const int s = r / I_UP; r -= s * I_UP; const int l = s >> 1, w = s & 1;
            const int kb = r / (NUP / 32), db = r % (NUP / 32), t = db >> 3, j = db & 7;
            const float* src = F.in[j < 4 ? (w ? I_F2G : I_F1G) : (w ? I_F2U : I_F1U)] + (size_t)l * D * FF;
            const float* gain = F.in[w ? I_F2N : I_F1N] + l * D;
            tr_item(src, FF, 64 * kb, 128 * t + 32 * (j & 3), 32, (bf16*)(F.ws + WS_WUP) + (size_t)s * NUP * D, D, 32 * db, gain, 1.0f, scr, lane);
            continue; }
        r -= T_UP;
        if (r < T_DN) {
            const int s = r / I_DN; r -= s * I_DN; const int l = s >> 1, w = s & 1;
            const int kb = r / (D / 32), db = r % (D / 32);
            const float* src = F.in[w ? I_F2D : I_F1D] + (size_t)l * FF * D;
            tr_item(src, D, 64 * kb, 32 * db, 32, (bf16*)(F.ws + WS_WDN) + (size_t)s * D * FF, FF, 32 * db, nullptr, 0.5f, scr, lane);
            continue; }
        r -= T_DN;
        if (r < T_IN) {
            const int l = r / I_IN; r -= l * I_IN;
            const int kb = r / (NIN / 32), db = r % (NIN / 32), r0 = 32 * db;
            int col, nvalid = 32; float scale = 1.0f;
            if (r0 < 1536) { col = r0; if (r0 < 256) scale = 0.125f; }
            else if (r0 < 2560) { const int t = (r0 - 1536) >> 8, w = (r0 - 1536) & 255; col = (w < 128) ? (1552 + 128 * t + w) : (2576 + 128 * t + (w - 128)); }
            else if (r0 < 3072) col = 2064 + (r0 - 2560);
            else if (r0 == 3072) { col = 1536; nvalid = 16; }
            else { col = 0; nvalid = 0; }
            tr_item(F.in[I_WIN] + (size_t)l * D * PROJ, PROJ, 64 * kb, col, nvalid, (bf16*)(F.ws + WS_WIN) + (size_t)l * NIN * D, D, r0, F.in[I_MIXN] + l * D, scale, scr, lane);
            continue; }
        r -= T_IN;
        {
            const int l = r / I_OUT; r -= l * I_OUT;
            const int kb = r / (D / 32), db = r % (D / 32);
            tr_item(F.in[I_WOUT] + (size_t)l * D * D, D, 64 * kb, 32 * db, 32, (bf16*)(F.ws + WS_WOUT) + (size_t)l * D * D, D, 32 * db, nullptr, 1.0f, scr, lane);
        }
    }
    u64* ssq0 = (u64*)(F.ws + WS_SSQ);
    for (int m = gw; m < M; m += NGW) {
        const GAS f32x4* xr = (const GAS f32x4*)(F.in[I_X] + (size_t)m * D) + lane;
        GAS v2u* o8 = (GAS v2u*)((bf16*)(F.ws + WS_XB) + (size_t)m * D) + lane;
        float s = 0.f;
#pragma unroll
        for (int j = 0; j < 4; ++j) { const f32x4 v = xr[64 * j]; s += (v.x * v.x + v.y * v.y) + (v.z * v.z + v.w * v.w); v2u o; o.x = pk_bf16(v.x, v.y); o.y = pk_bf16(v.z, v.w); o8[64 * j] = o; }
        s = wave_sum(s);
        if (lane == 0) ssq0[m] = pg8::ssq_fix(s);
    }
}

__device__ __forceinline__ void final_norm(Frame& F) {
    const int gw = blockIdx.x * NWAVES + F.wave, NGW = F.G * NWAVES, lane = F.lane;
    const u64* ssq = (const u64*)(F.ws + WS_SSQ) + (size_t)12 * M;
    const bf16* xb = (const bf16*)(F.ws + WS_XB);
    const float* gn = F.in[I_FINN];
    for (int m = gw; m < M; m += NGW) {
        const float rs = pg8::row_rstd(ssq, m);
#pragma unroll
        for (int j = 0; j < 2; ++j) {
            const int c = 8 * lane + 512 * j;
            const v4u w = *(const GAS v4u*)(xb + (size_t)m * D + c);
            const f32x4 g0 = *(const GAS f32x4*)(gn + c), g1 = *(const GAS f32x4*)(gn + c + 4);
            f32x4 o0, o1;
            o0.x = bf_lo(w.x) * rs * g0.x; o0.y = bf_hi(w.x) * rs * g0.y; o0.z = bf_lo(w.y) * rs * g0.z; o0.w = bf_hi(w.y) * rs * g0.w;
            o1.x = bf_lo(w.z) * rs * g1.x; o1.y = bf_hi(w.z) * rs * g1.y; o1.z = bf_lo(w.w) * rs * g1.z; o1.w = bf_hi(w.w) * rs * g1.w;
            *(GAS f32x4*)(F.out + (size_t)m * D + c) = o0; *(GAS f32x4*)(F.out + (size_t)m * D + c + 4) = o1;
        }
    }
}

__device__ __forceinline__ f32x16 mfma32(const LAS unsigned char* aimg, const LAS unsigned char* bimg, f32x16 c) {
    const pg8::bf16x8 a = *(const LAS pg8::bf16x8*)aimg, b = *(const LAS pg8::bf16x8*)bimg;
    return __builtin_amdgcn_mfma_f32_32x32x16_bf16(a, b, c, 0, 0, 0);
}
__device__ __forceinline__ float fexp(float x) { return __builtin_amdgcn_exp2f(x * 1.44269504089f); }
template <bool P2>
__device__ __forceinline__ void gla_pass(Frame& F, int layer) {
    LAS unsigned char* L = F.lds + RING_OFF;
    int tid_ = threadIdx.x; asm volatile("" : "+v"(tid_));
    const int tid = tid_, lane = tid & 63, w = __builtin_amdgcn_readfirstlane(tid >> 6), r = lane & 31, hh = lane >> 5;
    const bf16* Qb = (const bf16*)(F.ws + WS_Q); const bf16* Kb = (const bf16*)(F.ws + WS_K); const bf16* Vb = (const bf16*)(F.ws + WS_V);
    const bf16* SGb = (const bf16*)(F.ws + WS_SG); const bf16* ALRb = (const bf16*)(F.ws + WS_ALR); bf16* Yb = (bf16*)(F.ws + WS_Y);
    float* SEGS = (float*)(F.ws + WS_SEGS); float* SEGD = (float*)(F.ws + WS_SEGD);
    LAS float* LG = (LAS float*)(L + G_O); LAS float* OS = (LAS float*)(L + G_O);
    LAS bf16* QT = (LAS bf16*)(L + G_QT); LAS bf16* KT = (LAS bf16*)(L + G_KT); LAS bf16* KH = (LAS bf16*)(L + G_KH); LAS bf16* PS = (LAS bf16*)(L + G_P);
    LAS bf16* VT = (LAS bf16*)(L + G_VT); LAS bf16* ST = (LAS bf16*)(L + G_ST); LAS bf16* ALRs = (LAS bf16*)(L + G_ALR); LAS bf16* W2T = (LAS bf16*)(L + G_W2T);
    LAS float* GT = (LAS float*)(L + G_GT); LAS float* DS = (LAS float*)(L + G_D);
    const int kb = w >> 2, vb = w & 3;
    for (int u = blockIdx.x; u < NUNIT; u += F.G) {
        const int b = u >> 5, h = (u >> 3) & 3, sg = u & 7;
        const int tok0 = b * SEQ + sg * (SEGC * CHUNK);
        __syncthreads();
        { const int dk = tid & 63, rk = tid >> 6; const float* wa = F.in[I_WA2] + (size_t)layer * RANK * 256 + 64 * h + dk;
          W2T[dk * 24 + rk] = (bf16)(pk_bf16(wa[rk * 256], 0.f) & 0xffffu); W2T[dk * 24 + rk + 8] = (bf16)(pk_bf16(wa[(rk + 8) * 256], 0.f) & 0xffffu); }
        f32x16 S;
#pragma unroll
        for (int i = 0; i < 16; ++i) S[i] = 0.f;
        if (P2) {
            const int ub = u - sg;
            for (int sp = 0; sp < sg; ++sp) {
                const float* sd = SEGD + (size_t)(ub + sp) * 64 + 32 * kb; const float* ss = SEGS + ((size_t)(ub + sp) * 64 + 32 * kb) * 128 + 32 * vb + r;
#pragma unroll
                for (int i = 0; i < 16; ++i) { const int row = (i & 3) + 8 * (i >> 2) + 4 * hh; S[i] = S[i] * sd[row] + ss[(size_t)row * 128]; }
            }
#pragma unroll
            for (int i = 0; i < 4; ++i) { v2u o; o.x = pk_bf16(S[4 * i], S[4 * i + 1]); o.y = pk_bf16(S[4 * i + 2], S[4 * i + 3]);
                *(LAS v2u*)(ST + (32 * vb + r) * 72 + 32 * kb + 8 * i + 4 * hh) = o; }
        }
        float dsum = 0.f;
        for (int c = 0; c < SEGC; ++c) {
            const int t0 = tok0 + c * CHUNK;
            if (tid < 128) { const int tk = tid >> 1, hf = tid & 1; *(LAS v4u*)(ALRs + tk * 24 + 8 * hf) = *(const GAS v4u*)(ALRb + (size_t)(t0 + tk) * 16 + 8 * hf); }
            { const int dv = tid & 127, tg = tid >> 7; const bf16* vp = Vb + (size_t)(t0 + 16 * tg) * 512 + 128 * h + dv;
              unsigned short vv[16];
#pragma unroll
              for (int i = 0; i < 16; ++i) vv[i] = vp[(size_t)i * 512];
              v4u o0, o1; o0.x = vv[0] | ((unsigned)vv[1] << 16); o0.y = vv[2] | ((unsigned)vv[3] << 16); o0.z = vv[4] | ((unsigned)vv[5] << 16); o0.w = vv[6] | ((unsigned)vv[7] << 16);
              o1.x = vv[8] | ((unsigned)vv[9] << 16); o1.y = vv[10] | ((unsigned)vv[11] << 16); o1.z = vv[12] | ((unsigned)vv[13] << 16); o1.w = vv[14] | ((unsigned)vv[15] << 16);
              *(LAS v4u*)(VT + dv * 72 + 16 * tg) = o0; *(LAS v4u*)(VT + dv * 72 + 16 * tg + 8) = o1; }
            unsigned short qraw[8], kraw[8];
            { const int dk = tid & 63, grp = tid >> 6; const bf16* kp = Kb + (size_t)(t0 + 8 * grp) * 256 + 64 * h + dk; const bf16* qp = Qb + (size_t)(t0 + 8 * grp) * 256 + 64 * h + dk;
#pragma unroll
              for (int i = 0; i < 8; ++i) { kraw[i] = kp[(size_t)i * 256]; qraw[i] = P2 ? qp[(size_t)i * 256] : (unsigned short)0; } }
            __syncthreads();
            if (w < 4) {
                const int tb = w >> 1, db = w & 1;
                f32x16 acc;
#pragma unroll
                for (int i = 0; i < 16; ++i) acc[i] = 0.f;
                acc = mfma32((const LAS unsigned char*)(ALRs + (32 * tb + r) * 24 + 8 * hh), (const LAS unsigned char*)(W2T + (32 * db + r) * 24 + 8 * hh), acc);
                const float ba = F.in[I_BA][layer * 256 + 64 * h + 32 * db + r];
#pragma unroll
                for (int i = 0; i < 16; ++i) { const int row = (i & 3) + 8 * (i >> 2) + 4 * hh; const float x = acc[i] + ba;
                    const float e = __builtin_amdgcn_exp2f(-1.44269504089f * __builtin_fabsf(x));
                    const float ls = __builtin_fminf(x, 0.f) - 0.69314718056f * __builtin_amdgcn_logf(1.0f + e);
                    LG[(32 * tb + row) * 64 + 32 * db + r] = ls * (1.0f / 16.0f); }
            }
            __syncthreads();
            {
                const int dk = tid & 63, grp = tid >> 6;
                float p[8]; float run = 0.f;
#pragma unroll
                for (int i = 0; i < 8; ++i) { run += LG[(8 * grp + i) * 64 + dk]; p[i] = run; }
                GT[grp * 64 + dk] = run;
                __syncthreads();
                float off = 0.f, blast = 0.f;
#pragma unroll
                for (int g = 0; g < 8; ++g) { const float t = GT[g * 64 + dk]; blast += t; if (g < grp) off += t; }
                unsigned short kh[8];
#pragma unroll
                for (int i = 0; i < 8; ++i) {
                    const float bc = off + p[i]; const float kv = bf_lo((unsigned)kraw[i]);
                    kh[i] = (unsigned short)(pk_bf16(kv * fexp(blast - bc), 0.f) & 0xffffu);
                    if (P2) { const float qv = bf_lo((unsigned)qraw[i]);
                        QT[(8 * grp + i) * 72 + dk] = (bf16)(pk_bf16(qv * fexp(bc), 0.f) & 0xffffu);
                        KT[(8 * grp + i) * 72 + dk] = (bf16)(pk_bf16(kv * fexp(-bc), 0.f) & 0xffffu); }
                }
                v4u o; o.x = kh[0] | ((unsigned)kh[1] << 16); o.y = kh[2] | ((unsigned)kh[3] << 16); o.z = kh[4] | ((unsigned)kh[5] << 16); o.w = kh[6] | ((unsigned)kh[7] << 16);
                *(LAS v4u*)(KH + dk * 72 + 8 * grp) = o;
                if (grp == 0) { DS[dk] = fexp(blast); dsum += blast; }
            }
            __syncthreads();
            if (P2) {
                if (w < 3) {
                    const int tb = (w + 1) >> 1, jb = w >> 1;
                    f32x16 acc;
#pragma unroll
                    for (int i = 0; i < 16; ++i) acc[i] = 0.f;
#pragma unroll
                    for (int s = 0; s < 4; ++s) acc = mfma32((const LAS unsigned char*)(QT + (32 * tb + r) * 72 + 16 * s + 8 * hh), (const LAS unsigned char*)(KT + (32 * jb + r) * 72 + 16 * s + 8 * hh), acc);
#pragma unroll
                    for (int i = 0; i < 16; ++i) { const int tok = 32 * tb + (i & 3) + 8 * (i >> 2) + 4 * hh, tokp = 32 * jb + r;
                        PS[tok * 72 + tokp] = (bf16)(pk_bf16(tokp <= tok ? acc[i] : 0.f, 0.f) & 0xffffu); }
                }
                __syncthreads();
                {
                    const int tb = kb;
                    f32x16 acc;
#pragma unroll
                    for (int i = 0; i < 16; ++i) acc[i] = 0.f;
#pragma unroll
                    for (int s = 0; s < 4; ++s) if (s < 2 || tb) acc = mfma32((const LAS unsigned char*)(PS + (32 * tb + r) * 72 + 16 * s + 8 * hh), (const LAS unsigned char*)(VT + (32 * vb + r) * 72 + 16 * s + 8 * hh), acc);
#pragma unroll
                    for (int s = 0; s < 4; ++s) acc = mfma32((const LAS unsigned char*)(QT + (32 * tb + r) * 72 + 16 * s + 8 * hh), (const LAS unsigned char*)(ST + (32 * vb + r) * 72 + 16 * s + 8 * hh), acc);
#pragma unroll
                    for (int i = 0; i < 16; ++i) OS[(32 * tb + (i & 3) + 8 * (i >> 2) + 4 * hh) * 132 + 32 * vb + r] = acc[i];
                }
                __syncthreads();
                {
                    const int tok = tid >> 3, part = tid & 7;
                    const LAS f32x4* op = (const LAS f32x4*)(OS + tok * 132 + 16 * part);
                    const f32x4 o0 = op[0], o1 = op[1], o2 = op[2], o3 = op[3];
                    float ss = (o0.x * o0.x + o0.y * o0.y) + (o0.z * o0.z + o0.w * o0.w) + (o1.x * o1.x + o1.y * o1.y) + (o1.z * o1.z + o1.w * o1.w)
                             + (o2.x * o2.x + o2.y * o2.y) + (o2.z * o2.z + o2.w * o2.w) + (o3.x * o3.x + o3.y * o3.y) + (o3.z * o3.z + o3.w * o3.w);
                    ss += __shfl_xor(ss, 1); ss += __shfl_xor(ss, 2); ss += __shfl_xor(ss, 4);
                    const float rs = __builtin_amdgcn_rsqf(ss * (1.0f / 128.0f) + RMS_EPS);
                    const float* gn = F.in[I_GON] + layer * DV + 16 * part;
                    const f32x4 g0 = *(const GAS f32x4*)(gn), g1 = *(const GAS f32x4*)(gn + 4), g2 = *(const GAS f32x4*)(gn + 8), g3 = *(const GAS f32x4*)(gn + 12);
                    const bf16* sgp = SGb + (size_t)(t0 + tok) * 512 + 128 * h + 16 * part;
                    const v4u s0 = *(const GAS v4u*)sgp, s1 = *(const GAS v4u*)(sgp + 8);
                    v4u y0, y1;
                    y0.x = pk_bf16(o0.x * rs * g0.x * bf_lo(s0.x), o0.y * rs * g0.y * bf_hi(s0.x)); y0.y = pk_bf16(o0.z * rs * g0.z * bf_lo(s0.y), o0.w * rs * g0.w * bf_hi(s0.y));
                    y0.z = pk_bf16(o1.x * rs * g1.x * bf_lo(s0.z), o1.y * rs * g1.y * bf_hi(s0.z)); y0.w = pk_bf16(o1.z * rs * g1.z * bf_lo(s0.w), o1.w * rs * g1.w * bf_hi(s0.w));
                    y1.x = pk_bf16(o2.x * rs * g2.x * bf_lo(s1.x), o2.y * rs * g2.y * bf_hi(s1.x)); y1.y = pk_bf16(o2.z * rs * g2.z * bf_lo(s1.y), o2.w * rs * g2.w * bf_hi(s1.y));
                    y1.z = pk_bf16(o3.x * rs * g3.x * bf_lo(s1.z), o3.y * rs * g3.y * bf_hi(s1.z)); y1.w = pk_bf16(o3.z * rs * g3.z * bf_lo(s1.w), o3.w * rs * g3.w * bf_hi(s1.w));
                    bf16* yp = Yb + (size_t)(t0 + tok) * 1024 + 128 * h + 16 * part;
                    *(GAS v4u*)yp = y0; *(GAS v4u*)(yp + 8) = y1;
                }
            }
            {
#pragma unroll
                for (int i = 0; i < 16; ++i) S[i] *= DS[32 * kb + (i & 3) + 8 * (i >> 2) + 4 * hh];
#pragma unroll
                for (int s = 0; s < 4; ++s) S = mfma32((const LAS unsigned char*)(KH + (32 * kb + r) * 72 + 16 * s + 8 * hh), (const LAS unsigned char*)(VT + (32 * vb + r) * 72 + 16 * s + 8 * hh), S);
                if (P2) {
#pragma unroll
                    for (int i = 0; i < 4; ++i) { v2u o; o.x = pk_bf16(S[4 * i], S[4 * i + 1]); o.y = pk_bf16(S[4 * i + 2], S[4 * i + 3]);
                        *(LAS v2u*)(ST + (32 * vb + r) * 72 + 32 * kb + 8 * i + 4 * hh) = o; }
                }
            }
            __syncthreads();
        }
        if (!P2) {
#pragma unroll
            for (int i = 0; i < 16; ++i) SEGS[((size_t)u * 64 + 32 * kb + (i & 3) + 8 * (i >> 2) + 4 * hh) * 128 + 32 * vb + r] = S[i];
            if (tid < 64) SEGD[(size_t)u * 64 + tid] = fexp(dsum);
        }
    }
    if (!P2) {
        const bf16* CUb = (const bf16*)(F.ws + WS_CU); const bf16* GBb = (const bf16*)(F.ws + WS_GB);
        const int gt = blockIdx.x * NTHR + tid, cg = gt & 63;
        float wv[3][8];
#pragma unroll
        for (int j = 0; j < 3; ++j)
#pragma unroll
            for (int e = 0; e < 8; ++e) wv[j][e] = F.in[I_CONVW][(size_t)layer * 3 * 512 + j * 512 + 8 * cg + e];
        for (int t = gt >> 6; t < M; t += F.G * (NTHR / 64)) {
            const int pos = t & (SEQ - 1);
            const v4u zero = {0u, 0u, 0u, 0u};
            const v4u c2 = *(const GAS v4u*)(CUb + (size_t)t * 512 + 8 * cg);
            const v4u c1 = pos >= 1 ? *(const GAS v4u*)(CUb + (size_t)(t - 1) * 512 + 8 * cg) : zero;
            const v4u c0 = pos >= 2 ? *(const GAS v4u*)(CUb + (size_t)(t - 2) * 512 + 8 * cg) : zero;
            const v4u gb = *(const GAS v4u*)(GBb + (size_t)t * 512 + 8 * cg);
            float z[8];
#pragma unroll
            for (int e = 0; e < 4; ++e) {
                z[2 * e]     = bf_lo(gb[e]) * (wv[0][2 * e] * bf_lo(c0[e]) + wv[1][2 * e] * bf_lo(c1[e]) + wv[2][2 * e] * bf_lo(c2[e]));
                z[2 * e + 1] = bf_hi(gb[e]) * (wv[0][2 * e + 1] * bf_hi(c0[e]) + wv[1][2 * e + 1] * bf_hi(c1[e]) + wv[2][2 * e + 1] * bf_hi(c2[e]));
            }
            v4u o; o.x = pk_bf16(z[0], z[1]); o.y = pk_bf16(z[2], z[3]); o.z = pk_bf16(z[4], z[5]); o.w = pk_bf16(z[6], z[7]);
            *(GAS v4u*)(Yb + (size_t)t * 1024 + 512 + 8 * cg) = o;
        }
    }
}

#ifndef MK_N_LAUNCHES
#define MK_N_LAUNCHES 1
#endif
#ifndef PHM
#define PHM 0xff
#endif
constexpr int N_PHASES = 1 + NSLOT * 2 + DEPTH * 4 + 1;
struct Args { const float* in[N_IN]; float* out; unsigned char* ws; int ph_lo, ph_hi; };
static_assert(sizeof(Args) == (N_IN + 2) * 8 + 8, "Args has no padding");
__global__ void __launch_bounds__(NTHR, 2) mk_fwd(Args args) {
    extern __shared__ __attribute__((aligned(16))) unsigned char lds[];
    Frame F;
    F.lds = (LAS unsigned char*)lds;
    F.MISC = (volatile LAS unsigned*)(F.lds + MISC_OFF);
    F.tid = threadIdx.x; F.lane = F.tid & 63; F.wave = __builtin_amdgcn_readfirstlane(F.tid >> 6);
    F.G = gridDim.x;
    F.ws = args.ws; F.out = args.out; F.ctl = (gu32*)(args.ws + WS_CTL);
    F.in = args.in;
    for (int u = F.tid; u < (LDS_BYTES - LDSCTL_OFF) / 4; u += NTHR) ((LAS unsigned*)(F.lds + LDSCTL_OFF))[u] = 0u;
    __syncthreads();
    const int lo = args.ph_lo, hi = args.ph_hi;
    const bool one_launch = (hi - lo) > 1;
    XcdBarrier bar; bar.bar = (unsigned*)(F.ctl + CW_BAR); bar.x = 0; bar.st = nullptr;
    if (one_launch) bar = xcd_barrier_post((unsigned*)(F.ctl + CW_BAR), F.MISC + 8);
#define IN(k) (lo <= (k) && (k) < hi)
#define SEAM(k) do { if (IN(k) && IN((k) + 1)) xcd_barrier(bar); } while (0)
    bf16* XB = (bf16*)(F.ws + WS_XB); bf16* HB = (bf16*)(F.ws + WS_H); bf16* YB = (bf16*)(F.ws + WS_Y);
    u64* SSQ = (u64*)(F.ws + WS_SSQ);
    int p = 0;
    if (IN(p) && (PHM & 1)) p0_prologue(F);
    SEAM(p); ++p;
    for (int s = 0; s < NSLOT; ++s) {
        const int layer = s >> 1, ninst = 3 * layer + ((s & 1) ? 2 : 0);
        if (IN(p) && (PHM & 2)) {
            pg8::Gemm g{XB, (const bf16*)(F.ws + WS_WUP) + (size_t)s * NUP * D, M, NUP, D}; pg8::StaticOrder S; S.init(M, NUP, F.G, (int)blockIdx.x);
            pg8::EpiSwiGLU E{HB, SSQ + (size_t)ninst * M, FF};
            pg8::gemm_phase<pg8::EpiSwiGLU, pg8::StaticOrder, true, true>(F.lds + RING_OFF, g, S, E);
        }
        SEAM(p); ++p;
        if (IN(p) && (PHM & 4)) {
            pg8::Gemm g{HB, (const bf16*)(F.ws + WS_WDN) + (size_t)s * D * FF, M, D, FF}; pg8::StaticOrder S; S.init(M, D, F.G, (int)blockIdx.x);
            pg8::EpiResidual E{XB, SSQ + (size_t)(ninst + 1) * M};
            pg8::gemm_phase<pg8::EpiResidual, pg8::StaticOrder, true, true>(F.lds + RING_OFF, g, S, E);
        }
        SEAM(p); ++p;
        if (!(s & 1)) {
            if (IN(p) && (PHM & 8)) {
                pg8::Gemm g{XB, (const bf16*)(F.ws + WS_WIN) + (size_t)layer * NIN * D, M, NIN, D}; pg8::StaticOrder S; S.init(M, NIN, F.G, (int)blockIdx.x);
                pg8::EpiInProj E{(bf16*)(F.ws + WS_Q), (bf16*)(F.ws + WS_K), (bf16*)(F.ws + WS_V), (bf16*)(F.ws + WS_SG), (bf16*)(F.ws + WS_CU), (bf16*)(F.ws + WS_GB), (bf16*)(F.ws + WS_ALR), SSQ + (size_t)(3 * layer + 1) * M};
                pg8::gemm_phase<pg8::EpiInProj, pg8::StaticOrder, true, true>(F.lds + RING_OFF, g, S, E);
            }
            SEAM(p); ++p;
            if (IN(p) && (PHM & 16)) gla_pass<false>(F, layer);
            SEAM(p); ++p;
            if (IN(p) && (PHM & 32)) gla_pass<true>(F, layer);
            SEAM(p); ++p;
            if (IN(p) && (PHM & 64)) {
                pg8::Gemm g{YB, (const bf16*)(F.ws + WS_WOUT) + (size_t)layer * D * D, M, D, D}; pg8::StaticOrder S; S.init(M, D, F.G, (int)blockIdx.x);
                pg8::EpiResidual E{XB, SSQ + (size_t)(3 * layer + 2) * M};
                pg8::gemm_phase<pg8::EpiResidual, pg8::StaticOrder, true, true>(F.lds + RING_OFF, g, S, E);
            }
            SEAM(p); ++p;
        }
    }
    if (IN(p) && (PHM & 128)) final_norm(F);
#undef IN
#undef SEAM
}

extern "C" void kernel_launch(void* const* d_in, const int* in_sizes, int n_in, void* d_out, int out_size, void* d_ws, size_t ws_size, hipStream_t stream) {
    static int grid = 0;
    if (grid == 0) {
        if (n_in != N_IN || in_sizes[0] != M * D || out_size != M * D || ws_size < WS_END) {
            fprintf(stderr, "kernel_launch: built for %d inputs, x/out of %d floats, >= %zu bytes of workspace; got n_in %d, in0 %d, out %d, ws %zu; nothing launched\n", N_IN, M * D, (size_t)WS_END, n_in, n_in > 0 ? in_sizes[0] : -1, out_size, ws_size);
            grid = -1; return; }
        int dev = 0, cus = 0, per_cu = 0;
        if (hipGetDevice(&dev) != hipSuccess || hipDeviceGetAttribute(&cus, hipDeviceAttributeMultiprocessorCount, dev) != hipSuccess) { fprintf(stderr, "kernel_launch: device query failed\n"); grid = -1; return; }
        if (hipFuncSetAttribute((const void*)mk_fwd, hipFuncAttributeMaxDynamicSharedMemorySize, LDS_BYTES) != hipSuccess) { fprintf(stderr, "kernel_launch: hipFuncSetAttribute failed\n"); grid = -1; return; }
        if (hipOccupancyMaxActiveBlocksPerMultiprocessor(&per_cu, (const void*)mk_fwd, NTHR, LDS_BYTES) != hipSuccess || per_cu < 1)
            fprintf(stderr, "kernel_launch: note: occupancy query reports %d workgroups per CU\n", per_cu);
        (void)hipGetLastError();
        grid = cus;
    }
    if (grid < 0) return;
    if (hipMemsetAsync((char*)d_ws + WS_CTL, 0, CTL_ZERO_BYTES, stream) != hipSuccess) { fprintf(stderr, "kernel_launch: hipMemsetAsync failed\n"); return; }
    Args a{};
    for (int i = 0; i < N_IN; ++i) a.in[i] = (const float*)d_in[i];
    a.out = (float*)d_out; a.ws = (unsigned char*)d_ws;
#if MK_N_LAUNCHES == 1
    a.ph_lo = 0; a.ph_hi = N_PHASES;
    hipLaunchKernelGGL(mk_fwd, dim3(grid), dim3(NTHR), LDS_BYTES, stream, a);
#else
    for (int li = 0; li < N_PHASES; ++li) { a.ph_lo = li; a.ph_hi = li + 1; hipLaunchKernelGGL(mk_fwd, dim3(grid), dim3(NTHR), LDS_BYTES, stream, a); }
#endif
    const hipError_t le = hipPeekAtLastError();
    if (le != hipSuccess) fprintf(stderr, "kernel_launch: launch failed: %s\n", hipGetErrorName(le));
}
```

```cpp
#include <hip/hip_runtime.h>
#include <cstdio>
#include <cstdint>
#ifndef MK_N_LAUNCHES
#define MK_N_LAUNCHES 1
#endif
namespace pg8 {
#define PG8_LAS __attribute__((address_space(3)))
#define PG8_GAS __attribute__((address_space(1)))
typedef unsigned short bf16_t;
typedef short bf16x8 __attribute__((ext_vector_type(8)));
typedef float f32x4 __attribute__((ext_vector_type(4)));
typedef unsigned u32x4 __attribute__((ext_vector_type(4)));
constexpr int BM = 256, BK = 64, HALF = 128, HTB = HALF * BK * 2  , STAGE_BYTES = 8 * HTB, NXCD = 8;
#ifndef PG8_WGM
#define PG8_WGM 4
#endif
#ifndef PG8_SP2
#define PG8_SP2 true
#endif
#ifndef PG8_BAL
#define PG8_BAL 0
#endif
#ifndef PG8_PRIO_MMA
#define PG8_PRIO_MMA 1
#endif
#ifndef PG8_PRIO_LD
#define PG8_PRIO_LD 0
#endif
#ifndef PG8_DUMMY
#define PG8_DUMMY 0
#endif
#define PG8_DUMMY_LDS 148480
#ifndef PG8_MMA_PAD
#define PG8_MMA_PAD 0
#endif
#ifndef PG8_LD_PAD
#define PG8_LD_PAD 0
#endif
#ifndef PG8_EB
#define PG8_EB 0
#endif
#ifndef PG8_LATEBB
#define PG8_LATEBB 1
#endif
#ifndef PG8_ALIGN
#define PG8_ALIGN true
#endif
constexpr int WGM = PG8_WGM;

__host__ __device__ __forceinline__ int lds_byte(int r, int c) { const int st = (r >> 4) * 2 + (c >> 5), rr = r & 15, cc = c & 31, ob = rr * 64 + cc * 2; return st * 1024 + (ob ^ (((ob >> 9) & 1) << 5)); }
__host__ __device__ __forceinline__ void stage_rc(int b, int& R, int& C) { const int st = b / 1024, sb = b % 1024, swz = sb ^ (((sb >> 9) & 1) << 5); R = (st >> 1) * 16 + swz / 64; C = (st & 1) * 32 + (swz % 64) / 2; }
__host__ __device__ __forceinline__ int perm32(int rho) { const int n = rho >> 4, i = rho & 15; return 8 * (i >> 2) + 4 * n + (i & 3); }

struct Unit { int pm, pn; };
struct Gemm { const bf16_t* A; const bf16_t* Bt; int M, N, K; size_t abadj; int wave; };

struct StaticOrder {
    int nM, nN, nwg, G, c;
    __host__ __device__ void init(int M, int N, int G_, int c_) { nM = M / BM; nN = N / BM; nwg = nM * nN; G = G_; c = c_; }
    __host__ __device__ bool next(int i, Unit& u) const {
        const long L = (long)i * G + c; if (L >= nwg) return false;
        int wgid = (int)L; { const int q = nwg / NXCD, r = nwg % NXCD, xcd = wgid % NXCD, off = wgid / NXCD; wgid = (xcd < r ? xcd * (q + 1) : r * (q + 1) + (xcd - r) * q) + off; }
        const int nig = WGM * nN, gid = wgid / nig, fm = gid * WGM, gsz = (nM - fm) < WGM ? (nM - fm) : WGM;
        u.pm = fm + ((wgid % nig) % gsz); u.pn = (wgid % nig) / gsz; return true;
    }
    __device__ __forceinline__ void a_ready(const Unit&) const {}
    __device__ __forceinline__ void done(const Unit&) const {}
};

typedef float f32x2 __attribute__((ext_vector_type(2)));
typedef __bf16 bf16x2v __attribute__((ext_vector_type(2)));
typedef unsigned u32x2v __attribute__((ext_vector_type(2)));
constexpr float RMS_EPS = 1e-6f;
__device__ __forceinline__ unsigned pk_bf16(float lo, float hi) { const f32x2 v = {lo, hi}; return __builtin_bit_cast(unsigned, __builtin_convertvector(v, bf16x2v)); }
__device__ __forceinline__ float bf_lo(unsigned w) { return __builtin_bit_cast(float, w << 16); }
__device__ __forceinline__ float bf_hi(unsigned w) { return __builtin_bit_cast(float, w & 0xffff0000u); }
__device__ __forceinline__ float silu_f(float x) { return x * __builtin_amdgcn_rcpf(1.0f + __builtin_amdgcn_exp2f(-1.44269504089f * x)); }
constexpr float W8_SCALE = 32.0f;
__device__ __forceinline__ unsigned pk4_fp8(float a, float b, float c, float d) { int w = __builtin_amdgcn_cvt_pk_fp8_f32(a, b, 0, false); w = __builtin_amdgcn_cvt_pk_fp8_f32(c, d, w, true); return (unsigned)w; }
constexpr float SSQ_SCALE = 1048576.0f;
__device__ __forceinline__ unsigned long long ssq_fix(float s) { return (unsigned long long)(s * SSQ_SCALE + 0.5f); }
__device__ __forceinline__ float row_rstd(const unsigned long long* ssq, int r) { return __builtin_amdgcn_rsqf((float)((const PG8_GAS unsigned long long*)ssq)[r] * (1.0f / (1024.0f * SSQ_SCALE)) + RMS_EPS); }

__device__ __forceinline__ void rows_rstd(const unsigned long long* ssq, const PG8_LAS float* rt, int rbase, int row0, float (&rs)[2][4]) {
    if (rt) {
#pragma unroll
        for (int ai = 0; ai < 2; ++ai)
#pragma unroll
            for (int m = 0; m < 4; ++m) rs[ai][m] = rt[row0 - rbase + ai * HALF + m * 16];
        return; }
    unsigned long long q[2][4];
#pragma unroll
    for (int ai = 0; ai < 2; ++ai)
#pragma unroll
        for (int m = 0; m < 4; ++m) q[ai][m] = ((const PG8_GAS unsigned long long*)ssq)[row0 + ai * HALF + m * 16];
#pragma unroll
    for (int ai = 0; ai < 2; ++ai)
#pragma unroll
        for (int m = 0; m < 4; ++m) rs[ai][m] = __builtin_amdgcn_rsqf((float)q[ai][m] * (1.0f / (1024.0f * SSQ_SCALE)) + RMS_EPS);
    asm volatile("" ::: "memory");
}
template <bool F8IN, bool F8> struct EpiSwiGLUT {
    static constexpr bool PERM = true, AFTER_DRAIN = false;
    unsigned char* Hb; const unsigned long long* ssq; int ldhb; size_t hadj; const PG8_LAS float* rt; int rbase;
    __device__ __forceinline__ void group(const f32x4 (&acc)[2][2][4][2], int ai, int m, float rsr, f32x2 (&hp)[4]) const {
        const float rs = rsr * (F8IN ? 1.0f / W8_SCALE : 1.0f);
        const f32x2 c1 = {-1.44269504089f * rs, -1.44269504089f * rs};
        const float ir2 = __builtin_amdgcn_rcpf(rs * rs); const f32x2 c2 = {ir2, ir2};
#pragma unroll
        for (int n = 0; n < 2; ++n)
#pragma unroll
            for (int j = 0; j < 2; ++j) {
                const f32x2 g2 = {acc[ai][0][m][n][2 * j], acc[ai][0][m][n][2 * j + 1]}, u2 = {acc[ai][1][m][n][2 * j], acc[ai][1][m][n][2 * j + 1]};
                const f32x2 t2 = g2 * c1;
                f32x2 ex; ex.x = __builtin_amdgcn_exp2f(t2.x); ex.y = __builtin_amdgcn_exp2f(t2.y);
                const f32x2 d2 = ex * c2 + c2;
                f32x2 rr; rr.x = __builtin_amdgcn_rcpf(d2.x); rr.y = __builtin_amdgcn_rcpf(d2.y);
                hp[2 * n + j] = (g2 * u2) * rr;
            }
    }
    __device__ __forceinline__ void operator()(const f32x4 (&acc)[2][2][4][2], const Unit& u, int wr, int wc, int fr, int fq) const {
        const int row0 = u.pm * BM + wr * 64 + fr, col0 = u.pn * HALF + wc * 32 + 8 * fq;
        unsigned char* hb = Hb + (size_t)(u.pm >> 4) * hadj;
        float rsv[2][4]; rows_rstd(ssq, rt, rbase, row0, rsv);
#pragma unroll
        for (int ai = 0; ai < 2; ++ai)
#pragma unroll
            for (int mp = 0; mp < 2; ++mp) {
                const int rA = row0 + ai * HALF + (2 * mp) * 16, rB = rA + 16;
                f32x2 ha[4], hq[4];
                group(acc, ai, 2 * mp, rsv[ai][2 * mp], ha); group(acc, ai, 2 * mp + 1, rsv[ai][2 * mp + 1], hq);
                if (F8) {
                    u32x2v wa, wb; wa.x = pk4_fp8(ha[0].x, ha[0].y, ha[1].x, ha[1].y); wa.y = pk4_fp8(ha[2].x, ha[2].y, ha[3].x, ha[3].y);
                    wb.x = pk4_fp8(hq[0].x, hq[0].y, hq[1].x, hq[1].y); wb.y = pk4_fp8(hq[2].x, hq[2].y, hq[3].x, hq[3].y);
                    const u32x2v sx = __builtin_amdgcn_permlane16_swap(wa.x, wb.x, false, false), sy = __builtin_amdgcn_permlane16_swap(wa.y, wb.y, false, false);
                    u32x4 w; w.x = sx[0]; w.y = sy[0]; w.z = sx[1]; w.w = sy[1];
                    *(PG8_GAS u32x4*)(hb + (size_t)((fq & 1) ? rB : rA) * ldhb + (col0 - 8 * (fq & 1))) = w;
                } else {
                    u32x4 w; w.x = pk_bf16(ha[0].x, ha[0].y); w.y = pk_bf16(ha[1].x, ha[1].y); w.z = pk_bf16(ha[2].x, ha[2].y); w.w = pk_bf16(ha[3].x, ha[3].y); *(PG8_GAS u32x4*)(hb + (size_t)rA * ldhb + 2 * col0) = w;
                    u32x4 v; v.x = pk_bf16(hq[0].x, hq[0].y); v.y = pk_bf16(hq[1].x, hq[1].y); v.z = pk_bf16(hq[2].x, hq[2].y); v.w = pk_bf16(hq[3].x, hq[3].y); *(PG8_GAS u32x4*)(hb + (size_t)rB * ldhb + 2 * col0) = v;
                }
            }
    }
};
template <bool F8> struct EpiResidualT {
    static constexpr bool PERM = true, AFTER_DRAIN = false;
    bf16_t* X; unsigned long long* ssq_out; unsigned char* X8; size_t x8adj;
    __device__ __forceinline__ void operator()(const f32x4 (&acc)[2][2][4][2], const Unit& u, int wr, int wc, int fr, int fq) const {
        const int row0 = u.pm * BM + wr * 64 + fr, col0 = u.pn * BM + wc * 32 + 8 * fq;
        unsigned char* x8 = X8 ? X8 + (size_t)(u.pm >> 4) * x8adj : nullptr;
        constexpr int PF = 5;
        u32x4 xo[8][2]; float sq[8];
#pragma unroll
        for (int g = 0; g < PF; ++g)
#pragma unroll
            for (int bj = 0; bj < 2; ++bj) xo[g][bj] = *(const PG8_GAS u32x4*)(X + (size_t)(row0 + (g >> 2) * HALF + (g & 3) * 16) * 1024 + col0 + bj * HALF);
        const f32x2 asc = {F8 ? 1.0f / W8_SCALE : 1.0f, F8 ? 1.0f / W8_SCALE : 1.0f};
#pragma unroll
        for (int g = 0; g < 8; ++g) {
            const int ai = g >> 2, m = g & 3;
            const int r = row0 + ai * HALF + m * 16;
            bf16_t* rowp = X + (size_t)r * 1024 + col0;
            u32x2v w8[2] = {{0u, 0u}, {0u, 0u}};
            f32x2 s2 = {0.f, 0.f};
#pragma unroll
            for (int bj = 0; bj < 2; ++bj) {
                const u32x4 o = xo[g][bj];
                const f32x4 a0 = acc[ai][bj][m][0], a1 = acc[ai][bj][m][1];
                f32x2 p0, p1, p2, p3;
                if (F8) { p0 = (f32x2){a0[0], a0[1]} * asc + (f32x2){bf_lo(o.x), bf_hi(o.x)}; p1 = (f32x2){a0[2], a0[3]} * asc + (f32x2){bf_lo(o.y), bf_hi(o.y)};
                          p2 = (f32x2){a1[0], a1[1]} * asc + (f32x2){bf_lo(o.z), bf_hi(o.z)}; p3 = (f32x2){a1[2], a1[3]} * asc + (f32x2){bf_lo(o.w), bf_hi(o.w)}; }
                else    { p0 = (f32x2){bf_lo(o.x), bf_hi(o.x)} + (f32x2){a0[0], a0[1]}; p1 = (f32x2){bf_lo(o.y), bf_hi(o.y)} + (f32x2){a0[2], a0[3]};
                          p2 = (f32x2){bf_lo(o.z), bf_hi(o.z)} + (f32x2){a1[0], a1[1]}; p3 = (f32x2){bf_lo(o.w), bf_hi(o.w)} + (f32x2){a1[2], a1[3]}; }
                s2 = p0 * p0 + s2; s2 = p1 * p1 + s2; s2 = p2 * p2 + s2; s2 = p3 * p3 + s2;
                u32x4 w; w.x = pk_bf16(p0.x, p0.y); w.y = pk_bf16(p1.x, p1.y); w.z = pk_bf16(p2.x, p2.y); w.w = pk_bf16(p3.x, p3.y);
                *(PG8_GAS u32x4*)(rowp + bj * HALF) = w;
                if (x8) { w8[bj].x = pk4_fp8(p0.x, p0.y, p1.x, p1.y); w8[bj].y = pk4_fp8(p2.x, p2.y, p3.x, p3.y); }
            }
            if (x8) {
                const u32x2v sx = __builtin_amdgcn_permlane16_swap(w8[0].x, w8[1].x, false, false), sy = __builtin_amdgcn_permlane16_swap(w8[0].y, w8[1].y, false, false);
                u32x4 w; w.x = sx[0]; w.y = sy[0]; w.z = sx[1]; w.w = sy[1];
                *(PG8_GAS u32x4*)(x8 + (size_t)r * 1024 + (col0 - 8 * (fq & 1)) + (fq & 1) * HALF) = w;
            }
            sq[g] = s2.x + s2.y;
            if (g + PF < 8) {
                asm volatile("" ::: "memory");
#pragma unroll
                for (int bj = 0; bj < 2; ++bj) xo[g + PF][bj] = *(const PG8_GAS u32x4*)(X + (size_t)(row0 + ((g + PF) >> 2) * HALF + ((g + PF) & 3) * 16) * 1024 + col0 + bj * HALF);
            }
        }
#pragma unroll
        for (int g = 0; g < 8; ++g) sq[g] += __shfl_xor(sq[g], 16);
#pragma unroll
        for (int g = 0; g < 8; ++g) sq[g] += __shfl_xor(sq[g], 32);
#pragma unroll
        for (int g = 0; g < 8; ++g) {
            const int r = row0 + (g >> 2) * HALF + (g & 3) * 16;
            if (fq == 0) (void)__hip_atomic_fetch_add((PG8_GAS unsigned long long*)ssq_out + r, ssq_fix(sq[g]), __ATOMIC_RELAXED, __HIP_MEMORY_SCOPE_AGENT);
        }
    }
};
struct EpiInProj {
    static constexpr bool PERM = true, AFTER_DRAIN = false;
    bf16_t *Q, *K, *V, *SG, *CU, *GB; const unsigned long long* ssq; size_t adj512, adj1024; const PG8_LAS float* rt; int rbase;
    __device__ __forceinline__ void operator()(const f32x4 (&acc)[2][2][4][2], const Unit& u, int wr, int wc, int fr, int fq) const {
        const int row0 = u.pm * BM + wr * 64 + fr, pn = u.pn, cw = wc * 32 + 8 * fq;
        const size_t a512 = (size_t)(u.pm >> 4) * adj512, a1024 = (size_t)(u.pm >> 4) * adj1024;
        float rsv[2][4]; rows_rstd(ssq, rt, rbase, row0, rsv);
        if (pn >= 6 && pn <= 9) {
#pragma unroll
            for (int ai = 0; ai < 2; ++ai)
#pragma unroll
                for (int m = 0; m < 4; ++m) {
                    const int r = row0 + ai * HALF + m * 16; const float rs = rsv[ai][m], rs2 = rs * rs;
                    float hv[8];
#pragma unroll
                    for (int n = 0; n < 2; ++n)
#pragma unroll
                        for (int j = 0; j < 4; ++j) hv[4 * n + j] = (acc[ai][0][m][n][j] * acc[ai][1][m][n][j]) * rs2;
                    u32x4 w; w.x = pk_bf16(hv[0], hv[1]); w.y = pk_bf16(hv[2], hv[3]); w.z = pk_bf16(hv[4], hv[5]); w.w = pk_bf16(hv[6], hv[7]);
                    *(PG8_GAS u32x4*)(CU + a1024 + (size_t)r * 512 + (pn - 6) * HALF + cw) = w;
                }
        } else {
            bf16_t* base; int ldc, coff; bool act = false;
            if (pn == 0) { base = Q + a512; ldc = 256; coff = 0; }
            else if (pn == 1) { base = K + a512; ldc = 256; coff = 0; }
            else if (pn <= 3) { base = V + a1024; ldc = 512; coff = (pn - 2) * BM; }
            else if (pn <= 5) { base = SG + a1024; ldc = 512; coff = (pn - 4) * BM; act = true; }
            else { base = GB + a1024; ldc = 512; coff = (pn - 10) * BM; }
#pragma unroll
            for (int ai = 0; ai < 2; ++ai)
#pragma unroll
                for (int m = 0; m < 4; ++m) {
                    const int r = row0 + ai * HALF + m * 16; const float rs = rsv[ai][m];
                    bf16_t* rowp = base + (size_t)r * ldc + coff + cw;
#pragma unroll
                    for (int bj = 0; bj < 2; ++bj) {
                        f32x4 a0 = acc[ai][bj][m][0] * rs, a1 = acc[ai][bj][m][1] * rs;
                        if (act) {
#pragma unroll
                            for (int j = 0; j < 4; ++j) { a0[j] = silu_f(a0[j]); a1[j] = silu_f(a1[j]); }
                        }
                        u32x4 w; w.x = pk_bf16(a0[0], a0[1]); w.y = pk_bf16(a0[2], a0[3]); w.z = pk_bf16(a1[0], a1[1]); w.w = pk_bf16(a1[2], a1[3]);
                        *(PG8_GAS u32x4*)(rowp + bj * HALF) = w;
                    }
                }
        }
    }
};
typedef int v4i_t __attribute__((ext_vector_type(4)));
typedef int v8i_t __attribute__((ext_vector_type(8)));
__device__ __forceinline__ v8i_t cat8(bf16x8 lo, bf16x8 hi) { const v4i_t a = __builtin_bit_cast(v4i_t, lo), b = __builtin_bit_cast(v4i_t, hi); return __builtin_shufflevector(a, b, 0, 1, 2, 3, 4, 5, 6, 7); }
template <bool F> struct FragT;
template <> struct FragT<false> { bf16x8 k[2]; };
template <> struct FragT<true> { v8i_t v; };
template <class Epi, class Sched, bool ALIGN_EPI = false, bool SP2 = false, bool FP8 = false>
__device__ __forceinline__ void gemm_phase(PG8_LAS unsigned char* lds, const Gemm g, const Sched& S, const Epi& E) {
    int tid_ = g.wave * 64 + (int)__builtin_amdgcn_mbcnt_hi(~0u, __builtin_amdgcn_mbcnt_lo(~0u, 0u)); asm volatile("" : "+v"(tid_));
    const int tid = tid_, wid = __builtin_amdgcn_readfirstlane(tid >> 6), lane = tid & 63, wr = wid >> 2, wc = wid & 3, fr = lane & 15, fq = lane >> 4;
    const int K = g.K, nt = K / BK;
    unsigned voffA[2], voffB[2];
#pragma unroll
    for (int i = 0; i < 2; ++i) { int R, C; stage_rc(tid * 16 + i * 8192, R, C); const int Rb = Epi::PERM ? ((R & ~31) + perm32(R & 31)) : R;
        voffA[i] = (unsigned)(R * K + C) * 2u; voffB[i] = (unsigned)(Rb * K + C) * 2u; }
    const size_t kstep = (size_t)(BK * 2);
    const size_t hstep = (size_t)(unsigned)(HALF * K * 2);
    const size_t tstep = 2 * hstep;
    const unsigned ldsw = (unsigned)wid * 1024u;
    const int aoff = lds_byte(wr * 64 + fr, fq * 8), boff = lds_byte(wc * 32 + fr, fq * 8);
#define PG8_SA(b, h) (((b) * 2 + (h)) * HTB)
#define PG8_SB(b, h) ((4 + (b) * 2 + (h)) * HTB)
#define PG8_STAGE(bufoff, gbase, voff) do { _Pragma("unroll") for (int _i = 0; _i < 2; ++_i) \
        __builtin_amdgcn_global_load_lds((const unsigned*)((const char*)(gbase) + (voff)[_i]), (PG8_LAS unsigned*)(lds + (bufoff) + ldsw + _i * 8192), 16, 0, 0); } while (0)
#if PG8_DUMMY
#define PG8_DMY() do { _Pragma("unroll") for (int _d = 0; _d < PG8_DUMMY; ++_d) __builtin_amdgcn_global_load_lds((const unsigned*)((const char*)g.Bt + tid * 16), (PG8_LAS unsigned*)(lds + PG8_DUMMY_LDS + ldsw), 16, 0, 0); } while (0)
#define PG8_WAIT_V8() PG8_WAIT_V((8 + 2 * PG8_DUMMY))
#else
#define PG8_DMY() do { } while (0)
#define PG8_WAIT_V8() PG8_WAIT_V(8)
#endif
#if PG8_MMA_PAD
#define PG8_PADM() __builtin_amdgcn_s_sleep(PG8_MMA_PAD)
#else
#define PG8_PADM() do { } while (0)
#endif
#if PG8_LD_PAD
#define PG8_PADL() __builtin_amdgcn_s_sleep(PG8_LD_PAD)
#else
#define PG8_PADL() do { } while (0)
#endif
#define PG8_LDF(dst, off_) do { const bf16x8 f0_ = *(const PG8_LAS bf16x8*)(lds + (off_)), f1_ = *(const PG8_LAS bf16x8*)(lds + (off_) + 1024); \
        if constexpr (FP8) { (dst).v = cat8(f0_, f1_); } else { (dst).k[0] = f0_; (dst).k[1] = f1_; } } while (0)
#define PG8_LDA(dst, b, h) do { _Pragma("unroll") for (int m = 0; m < 4; ++m) PG8_LDF(dst[m], PG8_SA(b, h) + aoff + m * 2048); } while (0)
#define PG8_LDB(dst, b, h) do { _Pragma("unroll") for (int n = 0; n < 2; ++n) PG8_LDF(dst[n], PG8_SB(b, h) + boff + n * 2048); } while (0)
#if defined(__HIP_DEVICE_COMPILE__)
#define PG8_F8ASM(ai, bj, At, Bt) asm volatile("s_nop 1\n\t" \
            "v_mfma_scale_f32_16x16x128_f8f6f4 %0, %12, %8, %0, %14, %14 op_sel_hi:[0,0,0]\n\t"  "v_mfma_scale_f32_16x16x128_f8f6f4 %1, %13, %8, %1, %14, %14 op_sel_hi:[0,0,0]\n\t" \
            "v_mfma_scale_f32_16x16x128_f8f6f4 %2, %12, %9, %2, %14, %14 op_sel_hi:[0,0,0]\n\t"  "v_mfma_scale_f32_16x16x128_f8f6f4 %3, %13, %9, %3, %14, %14 op_sel_hi:[0,0,0]\n\t" \
            "v_mfma_scale_f32_16x16x128_f8f6f4 %4, %12, %10, %4, %14, %14 op_sel_hi:[0,0,0]\n\t" "v_mfma_scale_f32_16x16x128_f8f6f4 %5, %13, %10, %5, %14, %14 op_sel_hi:[0,0,0]\n\t" \
            "v_mfma_scale_f32_16x16x128_f8f6f4 %6, %12, %11, %6, %14, %14 op_sel_hi:[0,0,0]\n\t" "v_mfma_scale_f32_16x16x128_f8f6f4 %7, %13, %11, %7, %14, %14 op_sel_hi:[0,0,0]" \
            : "+v"(acc[ai][bj][0][0]), "+v"(acc[ai][bj][0][1]), "+v"(acc[ai][bj][1][0]), "+v"(acc[ai][bj][1][1]), "+v"(acc[ai][bj][2][0]), "+v"(acc[ai][bj][2][1]), "+v"(acc[ai][bj][3][0]), "+v"(acc[ai][bj][3][1]) \
            : "v"(At[0].v), "v"(At[1].v), "v"(At[2].v), "v"(At[3].v), "v"(Bt[0].v), "v"(Bt[1].v), "v"(sc127))
#else
#define PG8_F8ASM(ai, bj, At, Bt) ((void)sc127)
#endif
#if defined(__HIP_DEVICE_COMPILE__)
#define PG8_F8ASMH(ai, bj, At, Bt, m0) asm volatile("s_nop 1\n\t" \
            "v_mfma_scale_f32_16x16x128_f8f6f4 %0, %6, %4, %0, %8, %8 op_sel_hi:[0,0,0]\n\t" "v_mfma_scale_f32_16x16x128_f8f6f4 %1, %7, %4, %1, %8, %8 op_sel_hi:[0,0,0]\n\t" \
            "v_mfma_scale_f32_16x16x128_f8f6f4 %2, %6, %5, %2, %8, %8 op_sel_hi:[0,0,0]\n\t" "v_mfma_scale_f32_16x16x128_f8f6f4 %3, %7, %5, %3, %8, %8 op_sel_hi:[0,0,0]" \
            : "+v"(acc[ai][bj][m0][0]), "+v"(acc[ai][bj][m0][1]), "+v"(acc[ai][bj][m0 + 1][0]), "+v"(acc[ai][bj][m0 + 1][1]) \
            : "v"(At[m0].v), "v"(At[m0 + 1].v), "v"(Bt[0].v), "v"(Bt[1].v), "v"(sc127))
#else
#define PG8_F8ASMH(ai, bj, At, Bt, m0) ((void)sc127)
#endif
#if defined(__HIP_DEVICE_COMPILE__)
#define PG8_F8ASMQ(ai, bj, At, Bt, m_) asm volatile("s_nop 1\n\t" \
            "v_mfma_scale_f32_16x16x128_f8f6f4 %0, %3, %2, %0, %5, %5 op_sel_hi:[0,0,0]\n\t" "v_mfma_scale_f32_16x16x128_f8f6f4 %1, %4, %2, %1, %5, %5 op_sel_hi:[0,0,0]" \
            : "+v"(acc[ai][bj][m_][0]), "+v"(acc[ai][bj][m_][1]) : "v"(At[m_].v), "v"(Bt[0].v), "v"(Bt[1].v), "v"(sc127))
#else
#define PG8_F8ASMQ(ai, bj, At, Bt, m_) ((void)sc127)
#endif
#define PG8_MMA_H(ai, bj, At, Bt) do { __builtin_amdgcn_s_setprio(PG8_PRIO_MMA); \
        if constexpr (FP8) { PG8_F8ASMH(ai, bj, At, Bt, 0); PG8_F8ASMQ(ai, bj, At, Bt, 2); } \
        else { _Pragma("unroll") for (int m = 0; m < 4; ++m) _Pragma("unroll") for (int n = 0; n < 2; ++n) \
            acc[ai][bj][m][n] = __builtin_amdgcn_mfma_f32_16x16x32_bf16(Bt[n].k[0], At[m].k[0], acc[ai][bj][m][n], 0, 0, 0); \
          _Pragma("unroll") for (int m = 0; m < 2; ++m) _Pragma("unroll") for (int n = 0; n < 2; ++n) \
            acc[ai][bj][m][n] = __builtin_amdgcn_mfma_f32_16x16x32_bf16(Bt[n].k[1], At[m].k[1], acc[ai][bj][m][n], 0, 0, 0); } } while (0)
#define PG8_MMA_T(ai, bj, At, Bt) do { \
        if constexpr (FP8) { PG8_F8ASMQ(ai, bj, At, Bt, 3); } \
        else { _Pragma("unroll") for (int m = 2; m < 4; ++m) _Pragma("unroll") for (int n = 0; n < 2; ++n) \
            acc[ai][bj][m][n] = __builtin_amdgcn_mfma_f32_16x16x32_bf16(Bt[n].k[1], At[m].k[1], acc[ai][bj][m][n], 0, 0, 0); } \
        __builtin_amdgcn_s_setprio(PG8_PRIO_LD); } while (0)
#define PG8_MMA_LASTBAR(ai, bj, At, Bt) do { PG8_MMA(ai, bj, At, Bt); if (!(PG8_LATEBB && !ALIGN_EPI && last && wr == 1)) PG8_BAR; } while (0)
#if PG8_EB
#define PG8_MMA_BAR(ai, bj, At, Bt) do { PG8_MMA_H(ai, bj, At, Bt); PG8_SCHED; PG8_BAR; PG8_SCHED; PG8_MMA_T(ai, bj, At, Bt); } while (0)
#else
#define PG8_MMA_BAR(ai, bj, At, Bt) do { PG8_MMA(ai, bj, At, Bt); PG8_PADM(); PG8_BAR; } while (0)
#endif
#define PG8_MMA(ai, bj, At, Bt) do { __builtin_amdgcn_s_setprio(PG8_PRIO_MMA); \
        if constexpr (FP8) { PG8_F8ASM(ai, bj, At, Bt); } \
        else { _Pragma("unroll") for (int m = 0; m < 4; ++m) _Pragma("unroll") for (int n = 0; n < 2; ++n) _Pragma("unroll") for (int k = 0; k < 2; ++k) \
            acc[ai][bj][m][n] = __builtin_amdgcn_mfma_f32_16x16x32_bf16(Bt[n].k[k], At[m].k[k], acc[ai][bj][m][n], 0, 0, 0); } \
        __builtin_amdgcn_s_setprio(PG8_PRIO_LD); } while (0)
#define PG8_WAIT_V(n) do { asm volatile("" ::: "memory"); __builtin_amdgcn_s_waitcnt((((n) & 15) | 0x70 | 0xF00 | (((n) >> 4) << 14))); asm volatile("" ::: "memory"); } while (0)
#define PG8_WAIT_L(n) do { asm volatile("" ::: "memory"); __builtin_amdgcn_s_waitcnt((0xF | 0x70 | ((n) << 8) | (3 << 14))); asm volatile("" ::: "memory"); } while (0)
#define PG8_BAR __builtin_amdgcn_s_barrier()
#define PG8_SCHED __builtin_amdgcn_sched_barrier(0)
    Unit cur, nxt; int ui = 0;
    if (!S.next(0, cur)) return;
    f32x4 acc[2][2][4][2];
#pragma unroll
    for (int a = 0; a < 2; ++a)
#pragma unroll
        for (int b = 0; b < 2; ++b)
#pragma unroll
            for (int m = 0; m < 4; ++m)
#pragma unroll
                for (int n = 0; n < 2; ++n) acc[a][b][m][n] = (f32x4){0.f, 0.f, 0.f, 0.f};
    FragT<FP8> At[4], B0[2], B1[2];
    int sc127 = 127; asm volatile("" : "+v"(sc127));
    const char* cA = (const char*)g.A + (size_t)cur.pm * tstep + (size_t)(cur.pm >> 4) * g.abadj; const char* cB = (const char*)g.Bt + (size_t)cur.pn * tstep;
    S.a_ready(cur);
#if PG8_BAL
    if constexpr (SP2) {
        PG8_STAGE(PG8_SB(0, 0), cB, voffB); PG8_STAGE(PG8_SA(0, 0), cA, voffA); PG8_STAGE(PG8_SB(0, 1), cB + hstep, voffB); PG8_STAGE(PG8_SA(0, 1), cA + hstep, voffA);
        if (wr == 1) PG8_BAR;
        PG8_WAIT_V(0); PG8_BAR;
        PG8_STAGE(PG8_SB(1, 0), cB + kstep, voffB); PG8_STAGE(PG8_SA(1, 0), cA + kstep, voffA);
        PG8_BAR;
    } else
#endif
    if constexpr (SP2) {
        PG8_STAGE(PG8_SB(0, 0), cB, voffB); PG8_STAGE(PG8_SB(0, 1), cB + hstep, voffB); PG8_STAGE(PG8_SA(0, 0), cA, voffA); PG8_STAGE(PG8_SA(0, 1), cA + hstep, voffA);
        if (wr == 1) PG8_BAR;
        PG8_WAIT_V(2); PG8_BAR;
        PG8_STAGE(PG8_SB(1, 0), cB + kstep, voffB); PG8_STAGE(PG8_SA(1, 0), cA + kstep, voffA); PG8_STAGE(PG8_SB(1, 1), cB + hstep + kstep, voffB);
        PG8_WAIT_V(6); PG8_BAR;
    } else {
        PG8_STAGE(PG8_SB(0, 0), cB, voffB); PG8_STAGE(PG8_SA(0, 0), cA, voffA); PG8_STAGE(PG8_SB(0, 1), cB + hstep, voffB); PG8_STAGE(PG8_SA(0, 1), cA + hstep, voffA);
        if (wr == 1) PG8_BAR;
        PG8_WAIT_V(4); PG8_BAR;
        PG8_STAGE(PG8_SB(1, 0), cB + kstep, voffB); PG8_STAGE(PG8_SA(1, 0), cA + kstep, voffA); PG8_STAGE(PG8_SB(1, 1), cB + hstep + kstep, voffB);
        PG8_WAIT_V(6); PG8_BAR;
    }
    for (;;) {
        const bool has_next = S.next(ui + 1, nxt);
        const char* nA = has_next ? (const char*)g.A + (size_t)nxt.pm * tstep + (size_t)(nxt.pm >> 4) * g.abadj : cA; const char* nB = has_next ? (const char*)g.Bt + (size_t)nxt.pn * tstep : cB;
#pragma clang loop unroll(disable)
        for (int t = 0; t < nt; t += 2) {
            const bool last = (t == nt - 2);
            const char* a1 = cA + (size_t)(t + 1) * kstep;
            const char* a2 = last ? nA : cA + (size_t)(t + 2) * kstep; const char* b2 = last ? nB : cB + (size_t)(t + 2) * kstep;
            const char* a3 = a2 + kstep; const char* b3 = b2 + kstep;
            if (last && has_next) S.a_ready(nxt);
#if PG8_BAL
            if constexpr (SP2) {
            const char* b1 = cB + (size_t)(t + 1) * kstep;
            PG8_LDB(B0, 0, 0); PG8_SCHED; PG8_LDA(At, 0, 0); PG8_STAGE(PG8_SB(1, 1), b1 + hstep, voffB); PG8_STAGE(PG8_SA(1, 1), a1 + hstep, voffA);
            PG8_WAIT_V(8); PG8_WAIT_L(0); PG8_BAR; __builtin_amdgcn_s_setprio(1); PG8_LDB(B1, 0, 1); PG8_SCHED; PG8_MMA(0, 0, At, B0); PG8_MMA(0, 1, At, B1); PG8_BAR; PG8_SCHED;
            PG8_LDA(At, 0, 1); PG8_STAGE(PG8_SB(0, 0), b2, voffB); PG8_STAGE(PG8_SA(0, 0), a2, voffA);
            PG8_WAIT_V(8); PG8_WAIT_L(0); PG8_BAR; PG8_MMA(1, 0, At, B0); PG8_MMA(1, 1, At, B1); PG8_WAIT_V(6); PG8_BAR; PG8_SCHED;
            PG8_LDB(B0, 1, 0); PG8_SCHED; PG8_LDA(At, 1, 0); PG8_STAGE(PG8_SB(0, 1), b2 + hstep, voffB); PG8_STAGE(PG8_SA(0, 1), a2 + hstep, voffA);
            PG8_WAIT_V(8); PG8_WAIT_L(0); PG8_BAR; __builtin_amdgcn_s_setprio(1); PG8_LDB(B1, 1, 1); PG8_SCHED; PG8_MMA(0, 0, At, B0); PG8_MMA(0, 1, At, B1); PG8_BAR; PG8_SCHED;
            PG8_LDA(At, 1, 1); PG8_STAGE(PG8_SB(1, 0), b3, voffB); PG8_STAGE(PG8_SA(1, 0), a3, voffA);
            PG8_WAIT_V(8); PG8_WAIT_L(0); PG8_BAR; PG8_MMA(1, 0, At, B0); PG8_MMA(1, 1, At, B1); PG8_WAIT_V(6); PG8_BAR; PG8_SCHED;
            } else
#endif
            if constexpr (SP2) {
            PG8_LDB(B0, 0, 0); PG8_LDB(B1, 0, 1); PG8_SCHED; PG8_LDA(At, 0, 0); PG8_DMY(); PG8_STAGE(PG8_SA(1, 1), a1 + hstep, voffA);
            PG8_WAIT_V8(); PG8_WAIT_L(0); PG8_PADL(); PG8_BAR; PG8_MMA(0, 0, At, B0); PG8_MMA_BAR(0, 1, At, B1); PG8_SCHED;
            PG8_LDA(At, 0, 1); PG8_DMY(); PG8_STAGE(PG8_SB(0, 0), b2, voffB); PG8_STAGE(PG8_SB(0, 1), b2 + hstep, voffB); PG8_STAGE(PG8_SA(0, 0), a2, voffA);
            PG8_WAIT_V8(); PG8_WAIT_L(0); PG8_PADL(); PG8_BAR; PG8_MMA(1, 0, At, B0); PG8_MMA_BAR(1, 1, At, B1); PG8_SCHED;
            PG8_LDB(B0, 1, 0); PG8_LDB(B1, 1, 1); PG8_SCHED; PG8_LDA(At, 1, 0); PG8_DMY(); PG8_STAGE(PG8_SA(0, 1), a2 + hstep, voffA);
            PG8_WAIT_V8(); PG8_WAIT_L(0); PG8_PADL(); PG8_BAR; PG8_MMA(0, 0, At, B0); PG8_MMA_BAR(0, 1, At, B1); PG8_SCHED;
            PG8_LDA(At, 1, 1); PG8_DMY(); PG8_STAGE(PG8_SB(1, 0), b3, voffB); PG8_STAGE(PG8_SB(1, 1), b3 + hstep, voffB); PG8_STAGE(PG8_SA(1, 0), a3, voffA);
            PG8_WAIT_V8(); PG8_WAIT_L(0); PG8_PADL(); PG8_BAR; PG8_MMA(1, 0, At, B0); PG8_MMA_LASTBAR(1, 1, At, B1); PG8_SCHED;
            } else {
            PG8_LDB(B0, 0, 0); PG8_SCHED; PG8_LDA(At, 0, 0); PG8_STAGE(PG8_SA(1, 1), a1 + hstep, voffA);
            PG8_WAIT_L(8); PG8_BAR; PG8_WAIT_L(0); PG8_MMA(0, 0, At, B0); PG8_BAR; PG8_SCHED;
            PG8_LDB(B1, 0, 1); PG8_STAGE(PG8_SB(0, 0), b2, voffB);
            PG8_BAR; PG8_WAIT_L(0); PG8_MMA(0, 1, At, B1); PG8_BAR;
            PG8_LDA(At, 0, 1); PG8_STAGE(PG8_SA(0, 0), a2, voffA);
            PG8_BAR; PG8_WAIT_L(0); PG8_MMA(1, 0, At, B0); PG8_BAR; PG8_SCHED;
            PG8_STAGE(PG8_SB(0, 1), b2 + hstep, voffB);
            PG8_WAIT_V(6); PG8_BAR; PG8_MMA(1, 1, At, B1); PG8_BAR;
            PG8_LDB(B0, 1, 0); PG8_SCHED; PG8_LDA(At, 1, 0); PG8_STAGE(PG8_SA(0, 1), a2 + hstep, voffA);
            PG8_WAIT_L(8); PG8_BAR; PG8_WAIT_L(0); PG8_MMA(0, 0, At, B0); PG8_BAR; PG8_SCHED;
            PG8_LDB(B1, 1, 1); PG8_STAGE(PG8_SB(1, 0), b3, voffB);
            PG8_BAR; PG8_WAIT_L(0); PG8_MMA(0, 1, At, B1); PG8_BAR;
            PG8_LDA(At, 1, 1); PG8_STAGE(PG8_SA(1, 0), a3, voffA);
            PG8_BAR; PG8_WAIT_L(0); PG8_MMA(1, 0, At, B0); PG8_BAR; PG8_SCHED;
            PG8_STAGE(PG8_SB(1, 1), b3 + hstep, voffB);
            PG8_WAIT_V(6); PG8_BAR; PG8_MMA(1, 1, At, B1); PG8_BAR;
            }
        }
        if constexpr (FP8) asm volatile("s_nop 15\n\ts_nop 15" ::: "memory");
        if constexpr (ALIGN_EPI) { if (wr == 0) PG8_BAR; }
        if constexpr (!Epi::AFTER_DRAIN) { E(acc, cur, wr, wc, fr, fq); S.done(cur); }
        if constexpr (PG8_LATEBB && !ALIGN_EPI) { if (wr == 1) PG8_BAR; }
        if (!has_next) break;
#pragma unroll
        for (int a = 0; a < 2; ++a)
#pragma unroll
            for (int b = 0; b < 2; ++b)
#pragma unroll
                for (int m = 0; m < 4; ++m)
#pragma unroll
                    for (int n = 0; n < 2; ++n) acc[a][b][m][n] = (f32x4){0.f, 0.f, 0.f, 0.f};
        cur = nxt; cA = nA; cB = nB; ++ui;
        if constexpr (ALIGN_EPI) { if (wr == 1) PG8_BAR; }
    }
    PG8_WAIT_V(0);
    if constexpr (!ALIGN_EPI) { if (wr == 0) PG8_BAR; }
    PG8_BAR;
    if constexpr (Epi::AFTER_DRAIN) { E.fused(acc, cur, wr, wc, fr, fq, lds, wid, lane); S.done(cur); }
#undef PG8_SA
#undef PG8_SB
#undef PG8_STAGE
#undef PG8_PADM
#undef PG8_PADL
#undef PG8_DMY
#undef PG8_WAIT_V8
#undef PG8_LDF
#undef PG8_LDA
#undef PG8_LDB
#undef PG8_MMA
#undef PG8_MMA_H
#undef PG8_MMA_T
#undef PG8_MMA_BAR
#undef PG8_MMA_LASTBAR
#undef PG8_F8ASMH
#undef PG8_F8ASMQ
#undef PG8_F8ASM
#undef PG8_WAIT_V
#undef PG8_WAIT_L
#undef PG8_BAR
#undef PG8_SCHED
}
}
#define GAS __attribute__((address_space(1)))
#define LAS __attribute__((address_space(3)))
typedef unsigned short bf16;
typedef unsigned v4u __attribute__((ext_vector_type(4)));
typedef float f32x4 __attribute__((ext_vector_type(4)));
typedef short bf16x8 __attribute__((ext_vector_type(8)));
typedef GAS unsigned gu32;
typedef GAS unsigned long long gu64;
#define RLX_AGENT __ATOMIC_RELAXED, __HIP_MEMORY_SCOPE_AGENT
#define LDS_WAIT() asm volatile("s_waitcnt lgkmcnt(0)" ::: "memory")
#define VM_WAIT() asm volatile("s_waitcnt vmcnt(0)" ::: "memory")
__device__ __forceinline__ unsigned long long rt() { return __builtin_amdgcn_s_memrealtime(); }
__device__ __forceinline__ unsigned f2bf(float f) { unsigned u = __builtin_bit_cast(unsigned, f); return (u + 0x7fffu + ((u >> 16) & 1u)) >> 16; }
__device__ __forceinline__ unsigned pk2(float lo, float hi) { return f2bf(lo) | (f2bf(hi) << 16); }

#define XB_TMO      128
#define XB_XCNT(j)  (256  + 64 * (j))
#define XB_XSUB(j)  (1280 + 64 * (j))
#define XB_XGEN(j)  (2304 + 64 * (j))
#define XB_TOP      3328
#define XB_TOPGEN   3392
#define XCD_BAR_WORDS 3456
#define XB_SPIN_CAP (1u << 18)

__device__ __forceinline__ unsigned xb_ld(unsigned* p)              { return __hip_atomic_load(p, __ATOMIC_RELAXED, __HIP_MEMORY_SCOPE_AGENT); }
__device__ __forceinline__ unsigned xb_add(unsigned* p, unsigned v) { return __hip_atomic_fetch_add(p, v, __ATOMIC_RELAXED, __HIP_MEMORY_SCOPE_AGENT); }
__device__ __forceinline__ unsigned xb_xcc_id() { return (unsigned)__builtin_amdgcn_s_getreg((3 << 11) | 20) & 0xFu; }
#define XB_SPIN(cond, bar) do { unsigned _sp = 0; while (cond) { __builtin_amdgcn_s_sleep(1); \
    if ((++_sp & 255u) == 0u) { if (xb_ld(&(bar)[XB_TMO])) break; if (_sp > XB_SPIN_CAP) { atomicAdd(&(bar)[XB_TMO], 1u); break; } } } } while (0)

__device__ __forceinline__ int mk_lane() { return (int)__builtin_amdgcn_mbcnt_hi(~0u, __builtin_amdgcn_mbcnt_lo(~0u, 0u)); }
#define MK_TID(wave_) ((wave_) * 64 + mk_lane())
struct XcdBarrier {
    unsigned* bar; unsigned x;
    int wave;
    volatile LAS unsigned* st;
};

__device__ __forceinline__ XcdBarrier xcd_barrier_post(unsigned* bar, volatile LAS unsigned* st) {
    XcdBarrier b; b.bar = bar; b.x = xb_xcc_id(); b.st = st;
    if (threadIdx.x == 0) (void)xb_add(&bar[XB_XCNT(b.x)], 1u);
    return b;
}
__device__ __forceinline__ void xcd_barrier_complete(unsigned* bar, unsigned x, unsigned& nloc, unsigned& nx) {
    const unsigned G = gridDim.x * gridDim.y * gridDim.z;
    unsigned sum, cnt, mine, sp = 0u;
    for (;;) {
        sum = 0u; cnt = 0u; mine = 0u;
#pragma unroll
        for (unsigned j = 0; j < 16; ++j) { const unsigned c = xb_ld(&bar[XB_XCNT(j)]); sum += c; cnt += (c > 0u) ? 1u : 0u; mine = (j == x) ? c : mine; }
        if (sum == G) break;
        __builtin_amdgcn_s_sleep(1);
        if ((++sp & 255u) == 0u) { if (xb_ld(&bar[XB_TMO])) break; if (sp > XB_SPIN_CAP) { atomicAdd(&bar[XB_TMO], 1u); break; } }
    }
    nloc = mine > 0u ? mine : 1u; nx = cnt > 0u ? cnt : 1u;
}

__device__ __forceinline__ void xcd_barrier(const XcdBarrier& b) {
    asm volatile("s_waitcnt vmcnt(0)" ::: "memory");
    __syncthreads();
    if (b.wave == 0 && mk_lane() == 0) {
        unsigned* bar = b.bar;
        __builtin_amdgcn_s_waitcnt(0);
        unsigned nloc = b.st[0], nx = b.st[1];
        if (nloc == 0u) { xcd_barrier_complete(bar, b.x, nloc, nx); b.st[0] = nloc; b.st[1] = nx; }
        const unsigned old = xb_add(&bar[XB_XSUB(b.x)], 1u);
        const unsigned gen = old / nloc;
        if (old + 1u == (gen + 1u) * nloc) {
            __builtin_amdgcn_fence(__ATOMIC_RELEASE, "agent");
            asm volatile("s_waitcnt vmcnt(0)" ::: "memory");
            const unsigned og = xb_add(&bar[XB_TOP], 1u);
            const unsigned tg = og / nx;
            if (og + 1u == (tg + 1u) * nx) xb_add(&bar[XB_TOPGEN], 1u);
            else XB_SPIN(xb_ld(&bar[XB_TOPGEN]) == tg, bar);
            __builtin_amdgcn_fence(__ATOMIC_ACQUIRE, "agent");
            xb_add(&bar[XB_XGEN(b.x)], 1u);
            asm volatile("s_waitcnt vmcnt(0)" ::: "memory");
        } else {
            XB_SPIN(xb_ld(&bar[XB_XGEN(b.x)]) == gen, bar);
            __builtin_amdgcn_fence(__ATOMIC_ACQUIRE, "agent");
            asm volatile("s_waitcnt vmcnt(0)" ::: "memory");
        }
    }
    __syncthreads();
}


constexpr int D = 1024, BATCH = 8, SEQ = 4096, M = BATCH * SEQ, DEPTH = 4, FF = 2816, NUP = 2 * FF, PROJ = 3088, NIN = 3072;
constexpr int NH = 4, DK = 64, DV = 128, RANK = 16, CHUNK = 64, SEGC = 8  , NSEG = SEQ / (CHUNK * SEGC)  , NUNIT = BATCH * NH * NSEG  ;
constexpr int NSLOT = 2 * DEPTH;
#ifndef FP8_FROM
#define FP8_FROM 3
#endif
#ifndef PROBE_DUP
#define PROBE_DUP 0
#endif
#ifndef DN8_FROM
#define DN8_FROM 3
#endif
static_assert(FP8_FROM >= 1 && FP8_FROM <= 8 && DN8_FROM >= 0 && DN8_FROM <= FP8_FROM, "FP8_FROM / DN8_FROM");
constexpr int NWAVES = 8, NTHR = NWAVES * 64;
enum { I_X = 0, I_F1N, I_F1G, I_F1U, I_F1D, I_MIXN, I_WIN, I_WA2, I_BA, I_GON, I_CONVW, I_WOUT, I_F2N, I_F2G, I_F2U, I_F2D, I_FINN, N_IN };
constexpr size_t MiB = 1u << 20;
constexpr size_t WS_CTL = 0, WS_SSQ = 1 * MiB, CTL_ZERO_BYTES = 5 * MiB;
constexpr size_t WS_WUP = 6 * MiB;
constexpr size_t WS_WDN = 94 * MiB;
constexpr size_t WS_WIN = 138 * MiB;
constexpr size_t WS_WOUT = 164 * MiB;
constexpr size_t WS_XB = 172 * MiB;
constexpr size_t WS_H = 236 * MiB;
constexpr size_t HBB = (size_t)SEQ * FF * 2;
constexpr size_t WS_Q = WS_H, WS_K = WS_H + 2 * MiB, WS_V = WS_H + 4 * MiB, WS_SG = WS_H + 8 * MiB, WS_CU = WS_H + 12 * MiB, WS_GB = WS_H + 16 * MiB, WS_ALR = WS_H + 20 * MiB;
static_assert(20 * MiB + (size_t)SEQ * 32 <= HBB, "per-batch overlay fits inside the batch element's H rows");
__host__ __device__ constexpr size_t badj(int b, int rowbytes) { return (size_t)b * (HBB - (size_t)SEQ * rowbytes); }
constexpr size_t WS_Y = 412 * MiB;
constexpr size_t WS_SEGS = 476 * MiB;
constexpr size_t WS_SEGD = 484 * MiB;
constexpr size_t WS_WA = 485 * MiB;
constexpr size_t WS_END = 486 * MiB;
static_assert(WS_SSQ + (size_t)13 * M * 8 <= CTL_ZERO_BYTES && CTL_ZERO_BYTES <= WS_WUP, "ssq map");
static_assert(WS_H + (size_t)M * FF * 2 <= WS_Y, "d_ws map");
constexpr int CW_TMO = 0;
constexpr int CW_BAR = 4096;
constexpr int CW_GRP = 8192;
constexpr int RING_OFF = 0, RING_BYTES = 131072;
constexpr int LDSCTL_OFF = RING_BYTES, MISC_OFF = LDSCTL_OFF + 320;
constexpr int RST_OFF = LDSCTL_OFF + 1024;
static_assert(PG8_DUMMY_LDS == RST_OFF + 4096 * 4 - RING_OFF, "PG8_DUMMY_LDS");
constexpr int LDS_BYTES = RST_OFF + 4096 * 4 + (PG8_DUMMY ? 8192 : 0);
constexpr int G_O = 0;
constexpr int G_QT = 33792, G_KT = G_QT + 9216, G_KH = G_KT + 9216, G_P = G_KH + 9216;
constexpr int G_VT = G_P + 9216, G_ST = G_VT + 18432;
constexpr int G_ALR = G_ST + 18432, G_W2T = G_ALR + 3072;
constexpr int G_GT = G_W2T + 3072, G_D = G_GT + 2048, G_END = G_D + 256;
static_assert(G_END <= RING_BYTES, "GLA LDS map");

typedef unsigned long long u64;
typedef float f32x16 __attribute__((ext_vector_type(16)));
typedef unsigned v2u __attribute__((ext_vector_type(2)));
using pg8::pk_bf16; using pg8::bf_lo; using pg8::bf_hi; using pg8::RMS_EPS;

struct Frame {
    LAS unsigned char* lds;
    volatile LAS unsigned* MISC;
    gu32* ctl;
    int wave, G, c;
    const float* const* in; float* out; unsigned char* ws;
};

__device__ __forceinline__ float wave_sum(float v) {
#pragma unroll
    for (int o = 1; o < 64; o <<= 1) v += __shfl_xor(v, o);
    return v;
}

__device__ __forceinline__ void fill_rstd(Frame& F, int inst) {
    int tid_ = MK_TID(F.wave); asm volatile("" : "+v"(tid_));
    const u64* ssq = (const u64*)(F.ws + WS_SSQ) + (size_t)inst * M + (size_t)(F.c & 7) * SEQ;
    LAS float* rt = (LAS float*)(F.lds + RST_OFF);
    u64 q[SEQ / NTHR];
#pragma unroll
    for (int i = 0; i < SEQ / NTHR; ++i) q[i] = ssq[tid_ + i * NTHR];
#pragma unroll
    for (int i = 0; i < SEQ / NTHR; ++i) rt[tid_ + i * NTHR] = __builtin_amdgcn_rsqf((float)q[i] * (1.0f / (1024.0f * pg8::SSQ_SCALE)) + RMS_EPS);
    __syncthreads();
}
struct TrP { const float* src; int srcN, k0, scol0, nvalid; bf16* dst; int dstK, drow0; const float* gain; float scale; bool f8; };
__device__ __forceinline__ TrP tr_decode(Frame& F, int it) {
    constexpr int I_UP = (D / 64) * (NUP / 32), I_DN = (FF / 64) * (D / 32), I_IN = (D / 64) * (NIN / 32), I_OUT = (D / 64) * (D / 32);
    constexpr int T_UP = NSLOT * I_UP, T_DN = NSLOT * I_DN, T_IN = DEPTH * I_IN, T_OUT = DEPTH * I_OUT;
    int r = it;
    if (r < T_UP) {
        const int s = r / I_UP; r -= s * I_UP; const int l = s >> 1, w = s & 1;
        const int kb = r / (NUP / 32), db = r % (NUP / 32), t = db >> 3, j = db & 7;
        return TrP{F.in[j < 4 ? (w ? I_F2G : I_F1G) : (w ? I_F2U : I_F1U)] + (size_t)l * D * FF, FF, 64 * kb, 128 * t + 32 * (j & 3), 32, (bf16*)(F.ws + WS_WUP) + (size_t)s * NUP * D, D, 32 * db, F.in[w ? I_F2N : I_F1N] + l * D, s >= FP8_FROM ? pg8::W8_SCALE : 1.0f, s >= FP8_FROM}; }
    r -= T_UP;
    if (r < T_DN) {
        const int s = r / I_DN; r -= s * I_DN; const int l = s >> 1, w = s & 1;
        const int kb = r / (D / 32), db = r % (D / 32);
        return TrP{F.in[w ? I_F2D : I_F1D] + (size_t)l * FF * D, D, 64 * kb, 32 * db, 32, (bf16*)(F.ws + WS_WDN) + (size_t)s * D * FF, FF, 32 * db, nullptr, s >= DN8_FROM ? 0.5f * pg8::W8_SCALE : 0.5f, s >= DN8_FROM}; }
    r -= T_DN;
    if (r < T_IN) {
        const int l = r / I_IN; r -= l * I_IN;
        const int kb = r / (NIN / 32), db = r % (NIN / 32), r0 = 32 * db;
        int col; float scale = 1.0f;
        if (r0 < 1536) { col = r0; if (r0 < 256) scale = 0.125f; }
        else if (r0 < 2560) { const int t = (r0 - 1536) >> 8, w = (r0 - 1536) & 255; col = (w < 128) ? (1552 + 128 * t + w) : (2576 + 128 * t + (w - 128)); }
        else col = 2064 + (r0 - 2560);
        return TrP{F.in[I_WIN] + (size_t)l * D * PROJ, PROJ, 64 * kb, col, 32, (bf16*)(F.ws + WS_WIN) + (size_t)l * NIN * D, D, r0, F.in[I_MIXN] + l * D, scale, false}; }
    r -= T_IN;
    if (r >= T_OUT) {
        r -= T_OUT; const int l = r / (D / 64), kb = r % (D / 64);
        return TrP{F.in[I_WIN] + (size_t)l * D * PROJ, PROJ, 64 * kb, 1536, 16, (bf16*)(F.ws + WS_WA) + (size_t)l * 32 * D, D, 0, F.in[I_MIXN] + l * D, 1.0f, false}; }
    const int l = r / I_OUT; r -= l * I_OUT;
    const int kb = r / (D / 32), db = r % (D / 32);
    return TrP{F.in[I_WOUT] + (size_t)l * D * D, D, 64 * kb, 32 * db, 32, (bf16*)(F.ws + WS_WOUT) + (size_t)l * D * D, D, 32 * db, nullptr, 1.0f, false};
}
__device__ __forceinline__ void tr_load(const TrP& P, int lane, float (&v)[32]) {
    const int n = lane & 31; const float* sp = P.src + (size_t)(P.k0 + (lane >> 5)) * P.srcN + P.scol0 + n;
#pragma unroll
    for (int i = 0; i < 32; ++i) v[i] = (n < P.nvalid) ? sp[(size_t)(2 * i) * P.srcN] : 0.f;
}
__device__ __forceinline__ void tr_finish(const TrP& P, const float (&v)[32], LAS float* scr, int lane) {
    const int n = lane & 31;
#pragma unroll
    for (int i = 0; i < 32; ++i) scr[(2 * i + (lane >> 5)) * 33 + n] = v[i];
    const int c = lane & 7;
    float gv[8];
#pragma unroll
    for (int i = 0; i < 8; ++i) gv[i] = P.gain ? P.gain[P.k0 + 8 * c + i] * P.scale : P.scale;
    LDS_WAIT(); asm volatile("" ::: "memory");
    if (P.f8) {
#pragma unroll
        for (int j = 0; j < 4; ++j) { const int nn = (lane >> 3) + 8 * j; const LAS float* s = scr + (8 * c) * 33 + nn;
            v2u o; o.x = pg8::pk4_fp8(s[0 * 33] * gv[0], s[1 * 33] * gv[1], s[2 * 33] * gv[2], s[3 * 33] * gv[3]); o.y = pg8::pk4_fp8(s[4 * 33] * gv[4], s[5 * 33] * gv[5], s[6 * 33] * gv[6], s[7 * 33] * gv[7]);
            *(GAS v2u*)((unsigned char*)P.dst + (size_t)(P.drow0 + nn) * P.dstK + P.k0 + 8 * c) = o; }
    } else {
#pragma unroll
        for (int j = 0; j < 4; ++j) { const int nn = (lane >> 3) + 8 * j; const LAS float* s = scr + (8 * c) * 33 + nn;
            v4u o; o.x = pk_bf16(s[0 * 33] * gv[0], s[1 * 33] * gv[1]); o.y = pk_bf16(s[2 * 33] * gv[2], s[3 * 33] * gv[3]); o.z = pk_bf16(s[4 * 33] * gv[4], s[5 * 33] * gv[5]); o.w = pk_bf16(s[6 * 33] * gv[6], s[7 * 33] * gv[7]);
            *(GAS v4u*)(P.dst + (size_t)(P.drow0 + nn) * P.dstK + P.k0 + 8 * c) = o; }
    }
    LDS_WAIT(); asm volatile("" ::: "memory");
}
__device__ __forceinline__ void p0_prologue(Frame& F) {
    LAS float* scr = (LAS float*)(F.lds + RING_OFF + F.wave * 16384);
    int tid_ = MK_TID(F.wave); asm volatile("" : "+v"(tid_));
    const int gw = blockIdx.x * NWAVES + F.wave, NGW = F.G * NWAVES, lane = tid_ & 63;
    constexpr int NITEMS = NSLOT * (D / 64) * (NUP / 32) + NSLOT * (FF / 64) * (D / 32) + DEPTH * (D / 64) * (NIN / 32) + DEPTH * (D / 64) * (D / 32) + DEPTH * (D / 64);
    if (gw < NITEMS) {
        TrP pc = tr_decode(F, gw); float vc[32]; tr_load(pc, lane, vc);
        for (int it = gw; it < NITEMS; it += NGW) {
            const int nx = it + NGW; const bool more = nx < NITEMS;
            TrP pn = tr_decode(F, more ? nx : it); float vn[32];
            tr_load(pn, lane, vn);
            tr_finish(pc, vc, scr, lane);
            pc = pn;
#pragma unroll
            for (int i = 0; i < 32; ++i) vc[i] = vn[i];
        }
    }
    u64* ssq0 = (u64*)(F.ws + WS_SSQ);
    for (int m0 = 4 * gw; m0 < M; m0 += 4 * NGW) {
        f32x4 v[4][4];
#pragma unroll
        for (int q = 0; q < 4; ++q) { const GAS f32x4* xr = (const GAS f32x4*)(F.in[I_X] + (size_t)(m0 + q) * D) + lane;
#pragma unroll
            for (int j = 0; j < 4; ++j) v[q][j] = xr[64 * j]; }
#pragma unroll
        for (int q = 0; q < 4; ++q) { GAS v2u* o8 = (GAS v2u*)((bf16*)(F.ws + WS_XB) + (size_t)(m0 + q) * D) + lane; float s = 0.f;
#pragma unroll
            for (int j = 0; j < 4; ++j) { const f32x4 t = v[q][j]; s += (t.x * t.x + t.y * t.y) + (t.z * t.z + t.w * t.w); v2u o; o.x = pk_bf16(t.x, t.y); o.y = pk_bf16(t.z, t.w); o8[64 * j] = o; }
            s = wave_sum(s);
            if (lane == 0) ssq0[m0 + q] = pg8::ssq_fix(s); }
    }
}

__device__ __forceinline__ void final_norm(Frame& F) {
    int tid_ = MK_TID(F.wave); asm volatile("" : "+v"(tid_));
    const int lane = tid_ & 63;
    const u64* ssq = (const u64*)(F.ws + WS_SSQ) + (size_t)12 * M;
    const bf16* xb = (const bf16*)(F.ws + WS_XB);
    const float* gn = F.in[I_FINN];
    for (int uu = F.c; uu < 256; uu += F.G)
    for (int i0 = 0; i0 < 16; i0 += 4) {
        v4u w[4][2]; float rs[4];
#pragma unroll
        for (int q = 0; q < 4; ++q) { const int m = (uu & 7) * SEQ + (uu >> 3) * 128 + F.wave * 16 + i0 + q; rs[q] = pg8::row_rstd(ssq, m);
#pragma unroll
            for (int j = 0; j < 2; ++j) w[q][j] = *(const GAS v4u*)(xb + (size_t)m * D + 8 * lane + 512 * j); }
        f32x4 g[2][2];
#pragma unroll
        for (int j = 0; j < 2; ++j) { g[j][0] = *(const GAS f32x4*)(gn + 8 * lane + 512 * j); g[j][1] = *(const GAS f32x4*)(gn + 8 * lane + 512 * j + 4); }
        asm volatile("" ::: "memory");
#pragma unroll
        for (int q = 0; q < 4; ++q) { const int m = (uu & 7) * SEQ + (uu >> 3) * 128 + F.wave * 16 + i0 + q;
#pragma unroll
            for (int j = 0; j < 2; ++j) {
                const int c = 8 * lane + 512 * j; const v4u ww = w[q][j]; const f32x4 g0 = g[j][0], g1 = g[j][1]; const float r = rs[q];
                f32x4 o0, o1;
                o0.x = bf_lo(ww.x) * r * g0.x; o0.y = bf_hi(ww.x) * r * g0.y; o0.z = bf_lo(ww.y) * r * g0.z; o0.w = bf_hi(ww.y) * r * g0.w;
                o1.x = bf_lo(ww.z) * r * g1.x; o1.y = bf_hi(ww.z) * r * g1.y; o1.z = bf_lo(ww.w) * r * g1.z; o1.w = bf_hi(ww.w) * r * g1.w;
                *(GAS f32x4*)(F.out + (size_t)m * D + c) = o0; *(GAS f32x4*)(F.out + (size_t)m * D + c + 4) = o1;
            } }
    }
}

__device__ __forceinline__ void alr_units(Frame& F, int layer) {
    int tid_ = MK_TID(F.wave); asm volatile("" : "+v"(tid_));
    const int lane = tid_ & 63, w = __builtin_amdgcn_readfirstlane(tid_ >> 6), fr = lane & 15, fq = lane >> 4;
    const bf16* Xb = (const bf16*)(F.ws + WS_XB); const bf16* WA = (const bf16*)(F.ws + WS_WA) + (size_t)layer * 32 * D; bf16* ALRb = (bf16*)(F.ws + WS_ALR);
    const u64* ssq = (const u64*)(F.ws + WS_SSQ) + (size_t)(3 * layer + 1) * M;
    for (int u = F.c; u < M / 128; u += F.G) {
        const int x = u & 7, j = u >> 3;
        const int row0 = (16 * x + (j >> 1)) * 256 + (j & 1) * 128 + 16 * w;
        const bf16* ap = Xb + (size_t)(row0 + fr) * D + 8 * fq; const bf16* bp = WA + (size_t)fr * D + 8 * fq;
        f32x4 acc = {0.f, 0.f, 0.f, 0.f};
#pragma unroll 16
        for (int s = 0; s < D / 32; ++s) {
            const pg8::bf16x8 a = *(const GAS pg8::bf16x8*)(ap + 32 * s), b = *(const GAS pg8::bf16x8*)(bp + 32 * s);
            acc = __builtin_amdgcn_mfma_f32_16x16x32_bf16(a, b, acc, 0, 0, 0);
        }
#pragma unroll
        for (int i = 0; i < 4; ++i) { const int r = row0 + 4 * fq + i; ALRb[badj(x, 32) / 2 + (size_t)r * 16 + fr] = (bf16)(pk_bf16(acc[i] * pg8::row_rstd(ssq, r), 0.f) & 0xffffu); }
    }
}

__device__ __forceinline__ f32x16 mfma32(const LAS unsigned char* aimg, const LAS unsigned char* bimg, f32x16 c) {
    const pg8::bf16x8 a = *(const LAS pg8::bf16x8*)aimg, b = *(const LAS pg8::bf16x8*)bimg;
    return __builtin_amdgcn_mfma_f32_32x32x16_bf16(a, b, c, 0, 0, 0);
}
__device__ __forceinline__ float fexp(float x) { return __builtin_amdgcn_exp2f(x * 1.44269504089f); }
template <bool P2>
__device__ __forceinline__ void gla_pass(Frame& F, int layer) {
    LAS unsigned char* L = F.lds + RING_OFF;
    int tid_ = MK_TID(F.wave); asm volatile("" : "+v"(tid_));
    const int tid = tid_, lane = tid & 63, w = __builtin_amdgcn_readfirstlane(tid >> 6), r = lane & 31, hh = lane >> 5;
    const bf16* Qb0 = (const bf16*)(F.ws + WS_Q); const bf16* Kb0 = (const bf16*)(F.ws + WS_K); const bf16* Vb0 = (const bf16*)(F.ws + WS_V);
    const bf16* SGb0 = (const bf16*)(F.ws + WS_SG); const bf16* ALRb0 = (const bf16*)(F.ws + WS_ALR); bf16* Yb = (bf16*)(F.ws + WS_Y);
    float* SEGS = (float*)(F.ws + WS_SEGS); float* SEGD = (float*)(F.ws + WS_SEGD);
    LAS float* LG = (LAS float*)(L + G_O); LAS float* OS = (LAS float*)(L + G_O);
    LAS bf16* QT = (LAS bf16*)(L + G_QT); LAS bf16* KT = (LAS bf16*)(L + G_KT); LAS bf16* KH = (LAS bf16*)(L + G_KH); LAS bf16* PS = (LAS bf16*)(L + G_P);
    LAS bf16* VT = (LAS bf16*)(L + G_VT); LAS bf16* ST = (LAS bf16*)(L + G_ST); LAS bf16* ALRs = (LAS bf16*)(L + G_ALR); LAS bf16* W2T = (LAS bf16*)(L + G_W2T);
    LAS float* GT = (LAS float*)(L + G_GT); LAS float* DS = (LAS float*)(L + G_D);
    const int kb = w >> 2, vb = w & 3;
    for (int uu = F.c; uu < NUNIT; uu += F.G) {
        const int u = (uu & 7) * 32 + (uu >> 3);
        const int b = u >> 5, h = (u >> 3) & 3, sg = u & 7;
        const int tok0 = b * SEQ + sg * (SEGC * CHUNK);
        const bf16* Qb = Qb0 + badj(b, 512) / 2; const bf16* Kb = Kb0 + badj(b, 512) / 2; const bf16* Vb = Vb0 + badj(b, 1024) / 2; const bf16* SGb = SGb0 + badj(b, 1024) / 2; const bf16* ALRb = ALRb0 + badj(b, 32) / 2;
        __syncthreads();
        { const int dk = tid & 63, rk = tid >> 6; const float* wa = F.in[I_WA2] + (size_t)layer * RANK * 256 + 64 * h + dk;
          W2T[dk * 24 + rk] = (bf16)(pk_bf16(wa[rk * 256], 0.f) & 0xffffu); W2T[dk * 24 + rk + 8] = (bf16)(pk_bf16(wa[(rk + 8) * 256], 0.f) & 0xffffu); }
        f32x16 S;
#pragma unroll
        for (int i = 0; i < 16; ++i) S[i] = 0.f;
        if (P2) {
            const int ub = u - sg;
            for (int sp0 = 0; sp0 < sg; sp0 += 3) {
                float dv[3][16], sv[3][16];
#pragma unroll
                for (int q = 0; q < 3; ++q) {
                    const int sp = (sp0 + q < sg) ? sp0 + q : sg - 1;
                    const float* sd = SEGD + (size_t)(ub + sp) * 64 + 32 * kb; const float* ss = SEGS + ((size_t)(ub + sp) * 64 + 32 * kb) * 128 + 32 * vb + r;
#pragma unroll
                    for (int i = 0; i < 16; ++i) { const int row = (i & 3) + 8 * (i >> 2) + 4 * hh; dv[q][i] = sd[row]; sv[q][i] = ss[(size_t)row * 128]; }
                }
#pragma unroll
                for (int q = 0; q < 3; ++q) { const bool on = (sp0 + q < sg);
#pragma unroll
                    for (int i = 0; i < 16; ++i) S[i] = on ? S[i] * dv[q][i] + sv[q][i] : S[i]; }
            }
#pragma unroll
            for (int i = 0; i < 4; ++i) { v2u o; o.x = pk_bf16(S[4 * i], S[4 * i + 1]); o.y = pk_bf16(S[4 * i + 2], S[4 * i + 3]);
                *(LAS v2u*)(ST + (32 * vb + r) * 72 + 32 * kb + 8 * i + 4 * hh) = o; }
        }
        float dsum = 0.f;
        const float ba = F.in[I_BA][layer * 256 + 64 * h + 32 * (w & 1) + r];
        f32x4 g0 = {0.f, 0.f, 0.f, 0.f}, g1 = g0, g2 = g0, g3 = g0;
        if (P2) { const float* gn = F.in[I_GON] + layer * DV + 16 * (tid & 7); g0 = *(const GAS f32x4*)(gn); g1 = *(const GAS f32x4*)(gn + 4); g2 = *(const GAS f32x4*)(gn + 8); g3 = *(const GAS f32x4*)(gn + 12); }
        v4u nalr = {0u, 0u, 0u, 0u}, nsg0 = {0u, 0u, 0u, 0u}, nsg1 = {0u, 0u, 0u, 0u}; unsigned short nvv[16], nk[8], nq[8];
#define GLA_LOADS(t0_) do { const int tl_ = (t0_); \
            if (tid < 128) nalr = *(const GAS v4u*)(ALRb + (size_t)(tl_ + (tid >> 1)) * 16 + 8 * (tid & 1)); \
            { const bf16* vp_ = Vb + (size_t)(tl_ + 16 * (tid >> 7)) * 512 + 128 * h + (tid & 127); _Pragma("unroll") for (int i = 0; i < 16; ++i) nvv[i] = vp_[(size_t)i * 512]; } \
            { const size_t o_ = (size_t)(tl_ + 8 * (tid >> 6)) * 256 + 64 * h + (tid & 63); _Pragma("unroll") for (int i = 0; i < 8; ++i) { nk[i] = Kb[o_ + (size_t)i * 256]; nq[i] = P2 ? Qb[o_ + (size_t)i * 256] : (unsigned short)0; } } \
            if (P2) { const bf16* sp_ = SGb + (size_t)(tl_ + (tid >> 3)) * 512 + 128 * h + 16 * (tid & 7); nsg0 = *(const GAS v4u*)sp_; nsg1 = *(const GAS v4u*)(sp_ + 8); } } while (0)
        GLA_LOADS(tok0);
        for (int c = 0; c < SEGC; ++c) {
            const int t0 = tok0 + c * CHUNK;
            if (tid < 128) { const int tk = tid >> 1, hf = tid & 1; *(LAS v4u*)(ALRs + tk * 24 + 8 * hf) = nalr; }
            { const int dv = tid & 127, tg = tid >> 7;
              v4u o0, o1; o0.x = nvv[0] | ((unsigned)nvv[1] << 16); o0.y = nvv[2] | ((unsigned)nvv[3] << 16); o0.z = nvv[4] | ((unsigned)nvv[5] << 16); o0.w = nvv[6] | ((unsigned)nvv[7] << 16);
              o1.x = nvv[8] | ((unsigned)nvv[9] << 16); o1.y = nvv[10] | ((unsigned)nvv[11] << 16); o1.z = nvv[12] | ((unsigned)nvv[13] << 16); o1.w = nvv[14] | ((unsigned)nvv[15] << 16);
              *(LAS v4u*)(VT + dv * 72 + 16 * tg) = o0; *(LAS v4u*)(VT + dv * 72 + 16 * tg + 8) = o1; }
            unsigned short qraw[8], kraw[8];
#pragma unroll
            for (int i = 0; i < 8; ++i) { kraw[i] = nk[i]; qraw[i] = nq[i]; }
            const v4u s0 = nsg0, s1 = nsg1;
            { const int tn = t0 + CHUNK < M ? t0 + CHUNK : t0; GLA_LOADS(tn); }
            __syncthreads();
            if (w < 4) {
                const int tb = w >> 1, db = w & 1;
                f32x16 acc;
#pragma unroll
                for (int i = 0; i < 16; ++i) acc[i] = 0.f;
                acc = mfma32((const LAS unsigned char*)(ALRs + (32 * tb + r) * 24 + 8 * hh), (const LAS unsigned char*)(W2T + (32 * db + r) * 24 + 8 * hh), acc);
#pragma unroll
                for (int i = 0; i < 16; ++i) { const int row = (i & 3) + 8 * (i >> 2) + 4 * hh; const float x = acc[i] + ba;
                    const float e = __builtin_amdgcn_exp2f(-1.44269504089f * __builtin_fabsf(x));
                    const float ls = __builtin_fminf(x, 0.f) - 0.69314718056f * __builtin_amdgcn_logf(1.0f + e);
                    LG[(32 * tb + row) * 64 + 32 * db + r] = ls * (1.0f / 16.0f); }
            }
            __syncthreads();
            {
                const int dk = tid & 63, grp = tid >> 6;
                float p[8]; float run = 0.f;
#pragma unroll
                for (int i = 0; i < 8; ++i) { run += LG[(8 * grp + i) * 64 + dk]; p[i] = run; }
                GT[grp * 64 + dk] = run;
                __syncthreads();
                float off = 0.f, blast = 0.f;
#pragma unroll
                for (int g = 0; g < 8; ++g) { const float t = GT[g * 64 + dk]; blast += t; if (g < grp) off += t; }
                unsigned short kh[8];
#pragma unroll
                for (int i = 0; i < 8; ++i) {
                    const float bc = off + p[i]; const float kv = bf_lo((unsigned)kraw[i]);
                    kh[i] = (unsigned short)(pk_bf16(kv * fexp(blast - bc), 0.f) & 0xffffu);
                    if (P2) { const float qv = bf_lo((unsigned)qraw[i]);
                        QT[(8 * grp + i) * 72 + dk] = (bf16)(pk_bf16(qv * fexp(bc), 0.f) & 0xffffu);
                        KT[(8 * grp + i) * 72 + dk] = (bf16)(pk_bf16(kv * fexp(-bc), 0.f) & 0xffffu); }
                }
                v4u o; o.x = kh[0] | ((unsigned)kh[1] << 16); o.y = kh[2] | ((unsigned)kh[3] << 16); o.z = kh[4] | ((unsigned)kh[5] << 16); o.w = kh[6] | ((unsigned)kh[7] << 16);
                *(LAS v4u*)(KH + dk * 72 + 8 * grp) = o;
                if (grp == 0) { DS[dk] = fexp(blast); dsum += blast; }
            }
            __syncthreads();
            if (P2) {
                if (w < 3) {
                    const int tb = (w + 1) >> 1, jb = w >> 1;
                    f32x16 acc;
#pragma unroll
                    for (int i = 0; i < 16; ++i) acc[i] = 0.f;
#pragma unroll
                    for (int s = 0; s < 4; ++s) acc = mfma32((const LAS unsigned char*)(QT + (32 * tb + r) * 72 + 16 * s + 8 * hh), (const LAS unsigned char*)(KT + (32 * jb + r) * 72 + 16 * s + 8 * hh), acc);
#pragma unroll
                    for (int i = 0; i < 16; ++i) { const int tok = 32 * tb + (i & 3) + 8 * (i >> 2) + 4 * hh, tokp = 32 * jb + r;
                        PS[tok * 72 + tokp] = (bf16)(pk_bf16(tokp <= tok ? acc[i] : 0.f, 0.f) & 0xffffu); }
                }
                __syncthreads();
                {
                    const int tb = kb;
                    f32x16 acc;
#pragma unroll
                    for (int i = 0; i < 16; ++i) acc[i] = 0.f;
#pragma unroll
                    for (int s = 0; s < 4; ++s) if (s < 2 || tb) acc = mfma32((const LAS unsigned char*)(PS + (32 * tb + r) * 72 + 16 * s + 8 * hh), (const LAS unsigned char*)(VT + (32 * vb + r) * 72 + 16 * s + 8 * hh), acc);
#pragma unroll
                    for (int s = 0; s < 4; ++s) acc = mfma32((const LAS unsigned char*)(QT + (32 * tb + r) * 72 + 16 * s + 8 * hh), (const LAS unsigned char*)(ST + (32 * vb + r) * 72 + 16 * s + 8 * hh), acc);
#pragma unroll
                    for (int i = 0; i < 16; ++i) OS[(32 * tb + (i & 3) + 8 * (i >> 2) + 4 * hh) * 132 + 32 * vb + r] = acc[i];
                }
                __syncthreads();
                {
                    const int tok = tid >> 3, part = tid & 7;
                    const LAS f32x4* op = (const LAS f32x4*)(OS + tok * 132 + 16 * part);
                    const f32x4 o0 = op[0], o1 = op[1], o2 = op[2], o3 = op[3];
                    float ss = (o0.x * o0.x + o0.y * o0.y) + (o0.z * o0.z + o0.w * o0.w) + (o1.x * o1.x + o1.y * o1.y) + (o1.z * o1.z + o1.w * o1.w)
                             + (o2.x * o2.x + o2.y * o2.y) + (o2.z * o2.z + o2.w * o2.w) + (o3.x * o3.x + o3.y * o3.y) + (o3.z * o3.z + o3.w * o3.w);
                    ss += __shfl_xor(ss, 1); ss += __shfl_xor(ss, 2); ss += __shfl_xor(ss, 4);
                    const float rs = __builtin_amdgcn_rsqf(ss * (1.0f / 128.0f) + RMS_EPS);
                    v4u y0, y1;
                    y0.x = pk_bf16(o0.x * rs * g0.x * bf_lo(s0.x), o0.y * rs * g0.y * bf_hi(s0.x)); y0.y = pk_bf16(o0.z * rs * g0.z * bf_lo(s0.y), o0.w * rs * g0.w * bf_hi(s0.y));
                    y0.z = pk_bf16(o1.x * rs * g1.x * bf_lo(s0.z), o1.y * rs * g1.y * bf_hi(s0.z)); y0.w = pk_bf16(o1.z * rs * g1.z * bf_lo(s0.w), o1.w * rs * g1.w * bf_hi(s0.w));
                    y1.x = pk_bf16(o2.x * rs * g2.x * bf_lo(s1.x), o2.y * rs * g2.y * bf_hi(s1.x)); y1.y = pk_bf16(o2.z * rs * g2.z * bf_lo(s1.y), o2.w * rs * g2.w * bf_hi(s1.y));
                    y1.z = pk_bf16(o3.x * rs * g3.x * bf_lo(s1.z), o3.y * rs * g3.y * bf_hi(s1.z)); y1.w = pk_bf16(o3.z * rs * g3.z * bf_lo(s1.w), o3.w * rs * g3.w * bf_hi(s1.w));
                    bf16* yp = Yb + (size_t)(t0 + tok) * 1024 + 128 * h + 16 * part;
                    *(GAS v4u*)yp = y0; *(GAS v4u*)(yp + 8) = y1;
                }
            }
            {
#pragma unroll
                for (int i = 0; i < 16; ++i) S[i] *= DS[32 * kb + (i & 3) + 8 * (i >> 2) + 4 * hh];
#pragma unroll
                for (int s = 0; s < 4; ++s) S = mfma32((const LAS unsigned char*)(KH + (32 * kb + r) * 72 + 16 * s + 8 * hh), (const LAS unsigned char*)(VT + (32 * vb + r) * 72 + 16 * s + 8 * hh), S);
                if (P2) {
#pragma unroll
                    for (int i = 0; i < 4; ++i) { v2u o; o.x = pk_bf16(S[4 * i], S[4 * i + 1]); o.y = pk_bf16(S[4 * i + 2], S[4 * i + 3]);
                        *(LAS v2u*)(ST + (32 * vb + r) * 72 + 32 * kb + 8 * i + 4 * hh) = o; }
                }
            }
            __syncthreads();
        }
#undef GLA_LOADS
        if (!P2) {
#pragma unroll
            for (int i = 0; i < 16; ++i) SEGS[((size_t)u * 64 + 32 * kb + (i & 3) + 8 * (i >> 2) + 4 * hh) * 128 + 32 * vb + r] = S[i];
            if (tid < 64) SEGD[(size_t)u * 64 + tid] = fexp(dsum);
        }
    }
    if (!P2) {
        const int cg = tid & 63;
        float wv[3][8];
#pragma unroll
        for (int j = 0; j < 3; ++j)
#pragma unroll
            for (int e = 0; e < 8; ++e) wv[j][e] = F.in[I_CONVW][(size_t)layer * 3 * 512 + j * 512 + 8 * cg + e];
        for (int uu = F.c; uu < 256; uu += F.G) {
        const int cb = uu & 7;
        const bf16* CUb = (const bf16*)(F.ws + WS_CU) + badj(cb, 1024) / 2; const bf16* GBb = (const bf16*)(F.ws + WS_GB) + badj(cb, 1024) / 2;
        for (int k0 = 0; k0 < SEQ / 256; k0 += 4) {
            v4u c2[4], c1[4], c0[4], gb[4];
            const v4u zero = {0u, 0u, 0u, 0u};
#pragma unroll
            for (int q = 0; q < 4; ++q) {
                const int t = cb * SEQ + 256 * (k0 + q) + 8 * (uu >> 3) + (tid >> 6), pos = t & (SEQ - 1);
                c2[q] = *(const GAS v4u*)(CUb + (size_t)t * 512 + 8 * cg);
                c1[q] = pos >= 1 ? *(const GAS v4u*)(CUb + (size_t)(t - 1) * 512 + 8 * cg) : zero;
                c0[q] = pos >= 2 ? *(const GAS v4u*)(CUb + (size_t)(t - 2) * 512 + 8 * cg) : zero;
                gb[q] = *(const GAS v4u*)(GBb + (size_t)t * 512 + 8 * cg);
            }
            asm volatile("" ::: "memory");
#pragma unroll
            for (int q = 0; q < 4; ++q) {
                const int t = cb * SEQ + 256 * (k0 + q) + 8 * (uu >> 3) + (tid >> 6);
                float z[8];
#pragma unroll
                for (int e = 0; e < 4; ++e) {
                    z[2 * e]     = bf_lo(gb[q][e]) * (wv[0][2 * e] * bf_lo(c0[q][e]) + wv[1][2 * e] * bf_lo(c1[q][e]) + wv[2][2 * e] * bf_lo(c2[q][e]));
                    z[2 * e + 1] = bf_hi(gb[q][e]) * (wv[0][2 * e + 1] * bf_hi(c0[q][e]) + wv[1][2 * e + 1] * bf_hi(c1[q][e]) + wv[2][2 * e + 1] * bf_hi(c2[q][e]));
                }
                v4u o; o.x = pk_bf16(z[0], z[1]); o.y = pk_bf16(z[2], z[3]); o.z = pk_bf16(z[4], z[5]); o.w = pk_bf16(z[6], z[7]);
                *(GAS v4u*)(Yb + (size_t)t * 1024 + 512 + 8 * cg) = o;
            }
        }
        }
    }
}

__device__ __forceinline__ void grp_barrier(unsigned* cnt, unsigned* bar, int wave) {
    asm volatile("s_waitcnt vmcnt(0)" ::: "memory");
    __syncthreads();
    if (wave == 0 && mk_lane() == 0) {
        __builtin_amdgcn_s_waitcnt(0);
        const unsigned old = xb_add(cnt, 1u);
        const unsigned target = (old / 32u + 1u) * 32u;
        XB_SPIN(xb_ld(cnt) < target, bar);
        __builtin_amdgcn_fence(__ATOMIC_ACQUIRE, "agent");
        asm volatile("s_waitcnt vmcnt(0)" ::: "memory");
    }
    __syncthreads();
}
#ifndef LOCAL_SYNC
#define LOCAL_SYNC 1
#endif
constexpr size_t X8H_OFF = 12 * MiB, X8H_ADJ = HBB - (size_t)SEQ * 1024, X8Y_ADJ = (size_t)SEQ * 1024;
static_assert(X8H_OFF >= (size_t)SEQ * FF && X8H_OFF + (size_t)SEQ * 1024 <= HBB, "fp8 residual copy fits beside the fp8 hidden rows of its batch element");
#define IN(k) (lo <= (k) && (k) < hi)
#define SEAM(k) do { if (IN(k) && IN((k) + 1)) { if (lmode) grp_barrier(gcnt, bar.bar, F.wave); else xcd_barrier(bar); } } while (0)
__device__ __forceinline__ int opq(int v) { asm volatile("" : "+s"(v)); return v; }
template <bool F8, bool DN8>
__device__ __forceinline__ void run_slots(Frame& F, const XcdBarrier& bar, const bool lmode, unsigned* gcnt, const int lo, const int hi, int& p, const int s0, const int s1) {
    const bool tab = (F.G == 256);
    const LAS float* rtab = tab ? (const LAS float*)(F.lds + RST_OFF) : nullptr; const int rbase = (F.c & 7) * SEQ;
    for (int s = s0; s < s1; ++s) {
        const int layer = s >> 1, ninst = 3 * layer + ((s & 1) ? 2 : 0);
        if (IN(p)) {
            unsigned char* ws = F.ws; asm volatile("" : "+s"(ws));
            bf16* XB = (bf16*)(ws + WS_XB); unsigned char* HBy = ws + WS_H; u64* SSQ = (u64*)(ws + WS_SSQ);
            const bf16* A = F8 ? ((s & 1) ? (const bf16*)(ws + WS_H + X8H_OFF) : (const bf16*)(ws + WS_Y)) : XB;
            pg8::Gemm g{A, (const bf16*)(ws + WS_WUP) + (size_t)s * NUP * D, M, NUP, F8 ? D / 2 : D, F8 ? ((s & 1) ? X8H_ADJ : X8Y_ADJ) : (size_t)0, F.wave}; pg8::StaticOrder S; S.init(M, NUP, F.G, opq(F.c));
            if (tab) fill_rstd(F, ninst);
            pg8::EpiSwiGLUT<F8, DN8> E{HBy, SSQ + (size_t)ninst * M, DN8 ? FF : 2 * FF, DN8 ? HBB / 2 : (size_t)0, rtab, rbase};
            pg8::gemm_phase<pg8::EpiSwiGLUT<F8, DN8>, pg8::StaticOrder, PG8_ALIGN, PG8_SP2, F8>(F.lds + RING_OFF, g, S, E);
        }
        SEAM(p); ++p;
        if (IN(p)) {
            unsigned char* ws = F.ws; asm volatile("" : "+s"(ws));
            bf16* XB = (bf16*)(ws + WS_XB); unsigned char* HBy = ws + WS_H; u64* SSQ = (u64*)(ws + WS_SSQ);
            pg8::Gemm g{(const bf16*)HBy, (const bf16*)(ws + WS_WDN) + (size_t)s * D * FF, M, D, DN8 ? FF / 2 : FF, DN8 ? HBB / 2 : (size_t)0, F.wave}; pg8::StaticOrder S; S.init(M, D, F.G, opq(F.c));
            const bool nx8 = (s & 1) && (s + 1 >= FP8_FROM) && (s + 1 < NSLOT);
            pg8::EpiResidualT<DN8> E{XB, SSQ + (size_t)(ninst + 1) * M, nx8 ? ws + WS_Y : nullptr, X8Y_ADJ};
            pg8::gemm_phase<pg8::EpiResidualT<DN8>, pg8::StaticOrder, PG8_ALIGN, PG8_SP2, DN8>(F.lds + RING_OFF, g, S, E);
        }
        SEAM(p); ++p;
        if (!(s & 1)) {
            if (IN(p)) {
                unsigned char* ws = F.ws; asm volatile("" : "+s"(ws));
                bf16* XB = (bf16*)(ws + WS_XB); u64* SSQ = (u64*)(ws + WS_SSQ);
                pg8::Gemm g{XB, (const bf16*)(ws + WS_WIN) + (size_t)layer * NIN * D, M, NIN, D, 0, F.wave}; pg8::StaticOrder S; S.init(M, NIN, F.G, opq(F.c));
                if (tab) fill_rstd(F, 3 * layer + 1);
                pg8::EpiInProj E{(bf16*)(ws + WS_Q), (bf16*)(ws + WS_K), (bf16*)(ws + WS_V), (bf16*)(ws + WS_SG), (bf16*)(ws + WS_CU), (bf16*)(ws + WS_GB), SSQ + (size_t)(3 * layer + 1) * M, badj(1, 512) / 2, badj(1, 1024) / 2, rtab, rbase};
                pg8::gemm_phase<pg8::EpiInProj, pg8::StaticOrder, PG8_ALIGN, PG8_SP2, false>(F.lds + RING_OFF, g, S, E);
                alr_units(F, layer);
            }
            SEAM(p); ++p;
            if (IN(p)) { gla_pass<false>(F, layer); if (PROBE_DUP & 1) gla_pass<false>(F, layer); }
            SEAM(p); ++p;
            if (IN(p)) { gla_pass<true>(F, layer); if (PROBE_DUP & 2) gla_pass<true>(F, layer); }
            SEAM(p); ++p;
            if (IN(p)) {
                unsigned char* ws = F.ws; asm volatile("" : "+s"(ws));
                bf16* XB = (bf16*)(ws + WS_XB); bf16* YB = (bf16*)(ws + WS_Y); u64* SSQ = (u64*)(ws + WS_SSQ);
                pg8::Gemm g{YB, (const bf16*)(ws + WS_WOUT) + (size_t)layer * D * D, M, D, D, 0, F.wave}; pg8::StaticOrder S; S.init(M, D, F.G, opq(F.c));
                const bool nx8 = (s + 1 >= FP8_FROM);
                pg8::EpiResidualT<false> E{XB, SSQ + (size_t)(3 * layer + 2) * M, nx8 ? ws + WS_H + X8H_OFF : nullptr, X8H_ADJ};
                pg8::gemm_phase<pg8::EpiResidualT<false>, pg8::StaticOrder, PG8_ALIGN, PG8_SP2, false>(F.lds + RING_OFF, g, S, E);
            }
            SEAM(p); ++p;
        }
    }
}
#ifndef MK_N_LAUNCHES
#define MK_N_LAUNCHES 1
#endif
constexpr int N_PHASES = 1 + NSLOT * 2 + DEPTH * 4 + 1;
struct Args { const float* in[N_IN]; float* out; unsigned char* ws; int ph_lo, ph_hi; };
static_assert(sizeof(Args) == (N_IN + 2) * 8 + 8, "Args has no padding");
__global__ void __launch_bounds__(NTHR, 2) mk_fwd(Args args) {
    extern __shared__ __attribute__((aligned(16))) unsigned char lds[];
    Frame F;
    F.lds = (LAS unsigned char*)lds;
    F.MISC = (volatile LAS unsigned*)(F.lds + MISC_OFF);
    F.wave = __builtin_amdgcn_readfirstlane((int)threadIdx.x >> 6);
    F.G = gridDim.x;
    F.ws = args.ws; F.out = args.out; F.ctl = (gu32*)(args.ws + WS_CTL);
    F.in = args.in;
    for (int u = threadIdx.x; u < (LDS_BYTES - LDSCTL_OFF) / 4; u += NTHR) ((LAS unsigned*)(F.lds + LDSCTL_OFF))[u] = 0u;
    __syncthreads();
    const int lo = args.ph_lo, hi = args.ph_hi;
    const bool one_launch = (hi - lo) > 1;
    XcdBarrier bar; bar.bar = (unsigned*)(F.ctl + CW_BAR); bar.x = 0; bar.st = nullptr; bar.wave = F.wave;
    if (one_launch) {
        bar.x = xb_xcc_id(); bar.st = F.MISC + 8;
        if (threadIdx.x == 0) F.MISC[10] = xb_add(&bar.bar[XB_XCNT(bar.x)], 1u);
    }
    F.c = (int)blockIdx.x;
    bool lmode = false; unsigned* gcnt = (unsigned*)(F.ctl + CW_GRP);
    int p = 0;
    if (IN(p)) p0_prologue(F);
    SEAM(p); ++p;
    if (one_launch && LOCAL_SYNC) {
        if (threadIdx.x == 0) {
            unsigned ok = (gridDim.x == 256u) ? 1u : 0u, rank = 0u, npop = 0u;
            for (unsigned j = 0; j < 16; ++j) { const unsigned cn = xb_ld(&bar.bar[XB_XCNT(j)]); if (cn) { ++npop; if (cn != 32u) ok = 0u; if (j < bar.x) ++rank; } }
            if (npop != 8u) ok = 0u;
#if defined(FORCE_FALLBACK)
            ok = 0u;
#endif
            F.MISC[11] = ok; F.MISC[12] = rank;
        }
        __syncthreads();
        if (__builtin_amdgcn_readfirstlane((int)F.MISC[11]) != 0) {
            const int grp = __builtin_amdgcn_readfirstlane((int)F.MISC[12]);
            lmode = true; gcnt += 64 * grp;
            F.c = __builtin_amdgcn_readfirstlane(grp + 8 * (int)F.MISC[10]);
        }
    }
    run_slots<false, false>(F, bar, lmode, gcnt, lo, hi, p, 0, DN8_FROM);
    if constexpr (DN8_FROM < FP8_FROM) run_slots<false, true>(F, bar, lmode, gcnt, lo, hi, p, DN8_FROM, FP8_FROM);
    run_slots<true, true>(F, bar, lmode, gcnt, lo, hi, p, FP8_FROM, NSLOT);
    if (IN(p)) final_norm(F);
#undef IN
#undef SEAM
}

extern "C" void kernel_launch(void* const* d_in, const int* in_sizes, int n_in, void* d_out, int out_size, void* d_ws, size_t ws_size, hipStream_t stream) {
    static int grid = 0;
    if (grid == 0) {
        if (n_in != N_IN || in_sizes[0] != M * D || out_size != M * D || ws_size < WS_END) {
            fprintf(stderr, "kernel_launch: built for %d inputs, x/out of %d floats, >= %zu bytes of workspace; got n_in %d, in0 %d, out %d, ws %zu; nothing launched\n", N_IN, M * D, (size_t)WS_END, n_in, n_in > 0 ? in_sizes[0] : -1, out_size, ws_size);
            grid = -1; return; }
        int dev = 0, cus = 0, per_cu = 0;
        if (hipGetDevice(&dev) != hipSuccess || hipDeviceGetAttribute(&cus, hipDeviceAttributeMultiprocessorCount, dev) != hipSuccess) { fprintf(stderr, "kernel_launch: device query failed\n"); grid = -1; return; }
        if (hipFuncSetAttribute((const void*)mk_fwd, hipFuncAttributeMaxDynamicSharedMemorySize, LDS_BYTES) != hipSuccess) { fprintf(stderr, "kernel_launch: hipFuncSetAttribute failed\n"); grid = -1; return; }
        if (hipOccupancyMaxActiveBlocksPerMultiprocessor(&per_cu, (const void*)mk_fwd, NTHR, LDS_BYTES) != hipSuccess || per_cu < 1)
            fprintf(stderr, "kernel_launch: note: occupancy query reports %d workgroups per CU\n", per_cu);
        (void)hipGetLastError();
        grid = cus;
    }
    if (grid < 0) return;
    if (hipMemsetAsync((char*)d_ws + WS_CTL, 0, CTL_ZERO_BYTES, stream) != hipSuccess) { fprintf(stderr, "kernel_launch: hipMemsetAsync failed\n"); return; }
    Args a{};
    for (int i = 0; i < N_IN; ++i) a.in[i] = (const float*)d_in[i];
    a.out = (float*)d_out; a.ws = (unsigned char*)d_ws;
#if MK_N_LAUNCHES == 1
    a.ph_lo = 0; a.ph_hi = N_PHASES;
    hipLaunchKernelGGL(mk_fwd, dim3(grid), dim3(NTHR), LDS_BYTES, stream, a);
#else
    for (int li = 0; li < N_PHASES; ++li) { a.ph_lo = li; a.ph_hi = li + 1; hipLaunchKernelGGL(mk_fwd, dim3(grid), dim3(NTHR), LDS_BYTES, stream, a); }
#endif
    const hipError_t le = hipPeekAtLastError();
    if (le != hipSuccess) fprintf(stderr, "kernel_launch: launch failed: %s\n", hipGetErrorName(le));
}
```

```cpp
#include <hip/hip_runtime.h>
#include <cstdio>
#include <cstdint>
#ifndef MK_N_LAUNCHES
#define MK_N_LAUNCHES 1
#endif
namespace pg8 {
#define PG8_LAS __attribute__((address_space(3)))
#define PG8_GAS __attribute__((address_space(1)))
typedef unsigned short bf16_t;
typedef short bf16x8 __attribute__((ext_vector_type(8)));
typedef float f32x4 __attribute__((ext_vector_type(4)));
typedef unsigned u32x4 __attribute__((ext_vector_type(4)));
constexpr int BM = 256, BK = 64, HALF = 128, HTB = HALF * BK * 2  , STAGE_BYTES = 8 * HTB, NXCD = 8;
#ifndef PG8_WGM
#define PG8_WGM 4
#endif
#ifndef PG8_SP2
#define PG8_SP2 true
#endif
#ifndef PG8_BAL
#define PG8_BAL 0
#endif
#ifndef PG8_PRIO_MMA
#define PG8_PRIO_MMA 1
#endif
#ifndef PG8_PRIO_LD
#define PG8_PRIO_LD 0
#endif
#ifndef PG8_DUMMY
#define PG8_DUMMY 0
#endif
#define PG8_DUMMY_LDS 148480
#ifndef PG8_MMA_PAD
#define PG8_MMA_PAD 0
#endif
#ifndef PG8_LD_PAD
#define PG8_LD_PAD 0
#endif
#ifndef PG8_EB
#define PG8_EB 0
#endif
#ifndef PG8_LATEBB
#define PG8_LATEBB 1
#endif
#ifndef PG8_ALIGN
#define PG8_ALIGN true
#endif
constexpr int WGM = PG8_WGM;

__host__ __device__ __forceinline__ int lds_byte(int r, int c) { const int st = (r >> 4) * 2 + (c >> 5), rr = r & 15, cc = c & 31, ob = rr * 64 + cc * 2; return st * 1024 + (ob ^ (((ob >> 9) & 1) << 5)); }
__host__ __device__ __forceinline__ void stage_rc(int b, int& R, int& C) { const int st = b / 1024, sb = b % 1024, swz = sb ^ (((sb >> 9) & 1) << 5); R = (st >> 1) * 16 + swz / 64; C = (st & 1) * 32 + (swz % 64) / 2; }
__host__ __device__ __forceinline__ int perm32(int rho) { const int n = rho >> 4, i = rho & 15; return 8 * (i >> 2) + 4 * n + (i & 3); }

struct Unit { int pm, pn; };
struct Gemm { const bf16_t* A; const bf16_t* Bt; int M, N, K; size_t abadj; int wave; };

struct StaticOrder {
    int nM, nN, nwg, G, c;
    __host__ __device__ void init(int M, int N, int G_, int c_) { nM = M / BM; nN = N / BM; nwg = nM * nN; G = G_; c = c_; }
    __host__ __device__ bool next(int i, Unit& u) const {
        const long L = (long)i * G + c; if (L >= nwg) return false;
        int wgid = (int)L; { const int q = nwg / NXCD, r = nwg % NXCD, xcd = wgid % NXCD, off = wgid / NXCD; wgid = (xcd < r ? xcd * (q + 1) : r * (q + 1) + (xcd - r) * q) + off; }
        const int nig = WGM * nN, gid = wgid / nig, fm = gid * WGM, gsz = (nM - fm) < WGM ? (nM - fm) : WGM;
        u.pm = fm + ((wgid % nig) % gsz); u.pn = (wgid % nig) / gsz; return true;
    }
    __device__ __forceinline__ void a_ready(const Unit&) const {}
    __device__ __forceinline__ void done(const Unit&) const {}
};

typedef float f32x2 __attribute__((ext_vector_type(2)));
typedef __bf16 bf16x2v __attribute__((ext_vector_type(2)));
typedef unsigned u32x2v __attribute__((ext_vector_type(2)));
constexpr float RMS_EPS = 1e-6f;
__device__ __forceinline__ unsigned pk_bf16(float lo, float hi) { const f32x2 v = {lo, hi}; return __builtin_bit_cast(unsigned, __builtin_convertvector(v, bf16x2v)); }
__device__ __forceinline__ float bf_lo(unsigned w) { return __builtin_bit_cast(float, w << 16); }
__device__ __forceinline__ float bf_hi(unsigned w) { return __builtin_bit_cast(float, w & 0xffff0000u); }
__device__ __forceinline__ float silu_f(float x) { return x * __builtin_amdgcn_rcpf(1.0f + __builtin_amdgcn_exp2f(-1.44269504089f * x)); }
constexpr float W8_SCALE = 32.0f;
__device__ __forceinline__ unsigned pk4_fp8(float a, float b, float c, float d) { int w = __builtin_amdgcn_cvt_pk_fp8_f32(a, b, 0, false); w = __builtin_amdgcn_cvt_pk_fp8_f32(c, d, w, true); return (unsigned)w; }
constexpr float SSQ_SCALE = 1048576.0f;
__device__ __forceinline__ unsigned long long ssq_fix(float s) { return (unsigned long long)(s * SSQ_SCALE + 0.5f); }
__device__ __forceinline__ float row_rstd(const unsigned long long* ssq, int r) { return __builtin_amdgcn_rsqf((float)((const PG8_GAS unsigned long long*)ssq)[r] * (1.0f / (1024.0f * SSQ_SCALE)) + RMS_EPS); }

__device__ __forceinline__ void rows_rstd(const unsigned long long* ssq, const PG8_LAS float* rt, int rbase, int row0, float (&rs)[2][4]) {
    if (rt) {
#pragma unroll
        for (int ai = 0; ai < 2; ++ai)
#pragma unroll
            for (int m = 0; m < 4; ++m) rs[ai][m] = rt[row0 - rbase + ai * HALF + m * 16];
        return; }
    unsigned long long q[2][4];
#pragma unroll
    for (int ai = 0; ai < 2; ++ai)
#pragma unroll
        for (int m = 0; m < 4; ++m) q[ai][m] = ((const PG8_GAS unsigned long long*)ssq)[row0 + ai * HALF + m * 16];
#pragma unroll
    for (int ai = 0; ai < 2; ++ai)
#pragma unroll
        for (int m = 0; m < 4; ++m) rs[ai][m] = __builtin_amdgcn_rsqf((float)q[ai][m] * (1.0f / (1024.0f * SSQ_SCALE)) + RMS_EPS);
    asm volatile("" ::: "memory");
}
template <bool F8IN, bool F8> struct EpiSwiGLUT {
    static constexpr bool PERM = true, AFTER_DRAIN = false;
    static constexpr int VMEM_LB = F8 ? 4 : 8;
    unsigned char* Hb; const unsigned long long* ssq; int ldhb; size_t hadj; const PG8_LAS float* rt; int rbase;
    __device__ __forceinline__ void group(const f32x4 (&acc)[2][2][4][2], int ai, int m, float rsr, f32x2 (&hp)[4]) const {
        const float rs = rsr * (F8IN ? 1.0f / W8_SCALE : 1.0f);
        const f32x2 c1 = {-1.44269504089f * rs, -1.44269504089f * rs};
        const float ir2 = __builtin_amdgcn_rcpf(rs * rs); const f32x2 c2 = {ir2, ir2};
#pragma unroll
        for (int n = 0; n < 2; ++n)
#pragma unroll
            for (int j = 0; j < 2; ++j) {
                const f32x2 g2 = {acc[ai][0][m][n][2 * j], acc[ai][0][m][n][2 * j + 1]}, u2 = {acc[ai][1][m][n][2 * j], acc[ai][1][m][n][2 * j + 1]};
                const f32x2 t2 = g2 * c1;
                f32x2 ex; ex.x = __builtin_amdgcn_exp2f(t2.x); ex.y = __builtin_amdgcn_exp2f(t2.y);
                const f32x2 d2 = ex * c2 + c2;
                f32x2 rr; rr.x = __builtin_amdgcn_rcpf(d2.x); rr.y = __builtin_amdgcn_rcpf(d2.y);
                hp[2 * n + j] = (g2 * u2) * rr;
            }
    }
    __device__ __forceinline__ void operator()(const f32x4 (&acc)[2][2][4][2], const Unit& u, int wr, int wc, int fr, int fq) const {
        const int row0 = u.pm * BM + wr * 64 + fr, col0 = u.pn * HALF + wc * 32 + 8 * fq;
        unsigned char* hb = Hb + (size_t)(u.pm >> 4) * hadj;
        float rsv[2][4]; rows_rstd(ssq, rt, rbase, row0, rsv);
#pragma unroll
        for (int ai = 0; ai < 2; ++ai)
#pragma unroll
            for (int mp = 0; mp < 2; ++mp) {
                const int rA = row0 + ai * HALF + (2 * mp) * 16, rB = rA + 16;
                f32x2 ha[4], hq[4];
                group(acc, ai, 2 * mp, rsv[ai][2 * mp], ha); group(acc, ai, 2 * mp + 1, rsv[ai][2 * mp + 1], hq);
                if (F8) {
                    u32x2v wa, wb; wa.x = pk4_fp8(ha[0].x, ha[0].y, ha[1].x, ha[1].y); wa.y = pk4_fp8(ha[2].x, ha[2].y, ha[3].x, ha[3].y);
                    wb.x = pk4_fp8(hq[0].x, hq[0].y, hq[1].x, hq[1].y); wb.y = pk4_fp8(hq[2].x, hq[2].y, hq[3].x, hq[3].y);
                    const u32x2v sx = __builtin_amdgcn_permlane16_swap(wa.x, wb.x, false, false), sy = __builtin_amdgcn_permlane16_swap(wa.y, wb.y, false, false);
                    u32x4 w; w.x = sx[0]; w.y = sy[0]; w.z = sx[1]; w.w = sy[1];
                    *(PG8_GAS u32x4*)(hb + (size_t)((fq & 1) ? rB : rA) * ldhb + (col0 - 8 * (fq & 1))) = w;
                } else {
                    u32x4 w; w.x = pk_bf16(ha[0].x, ha[0].y); w.y = pk_bf16(ha[1].x, ha[1].y); w.z = pk_bf16(ha[2].x, ha[2].y); w.w = pk_bf16(ha[3].x, ha[3].y); *(PG8_GAS u32x4*)(hb + (size_t)rA * ldhb + 2 * col0) = w;
                    u32x4 v; v.x = pk_bf16(hq[0].x, hq[0].y); v.y = pk_bf16(hq[1].x, hq[1].y); v.z = pk_bf16(hq[2].x, hq[2].y); v.w = pk_bf16(hq[3].x, hq[3].y); *(PG8_GAS u32x4*)(hb + (size_t)rB * ldhb + 2 * col0) = v;
                }
            }
    }
};
template <bool F8> struct EpiResidualT {
    static constexpr bool PERM = true, AFTER_DRAIN = false;
    static constexpr int VMEM_LB = 40;
    bf16_t* X; unsigned long long* ssq_out; unsigned char* X8; size_t x8adj;
    __device__ __forceinline__ void operator()(const f32x4 (&acc)[2][2][4][2], const Unit& u, int wr, int wc, int fr, int fq) const {
        const int row0 = u.pm * BM + wr * 64 + fr, col0 = u.pn * BM + wc * 32 + 8 * fq;
        unsigned char* x8 = X8 ? X8 + (size_t)(u.pm >> 4) * x8adj : nullptr;
        constexpr int PF = 5;
        u32x4 xo[8][2]; float sq[8];
#pragma unroll
        for (int g = 0; g < PF; ++g)
#pragma unroll
            for (int bj = 0; bj < 2; ++bj) xo[g][bj] = *(const PG8_GAS u32x4*)(X + (size_t)(row0 + (g >> 2) * HALF + (g & 3) * 16) * 1024 + col0 + bj * HALF);
        const f32x2 asc = {F8 ? 1.0f / W8_SCALE : 1.0f, F8 ? 1.0f / W8_SCALE : 1.0f};
#pragma unroll
        for (int g = 0; g < 8; ++g) {
            const int ai = g >> 2, m = g & 3;
            const int r = row0 + ai * HALF + m * 16;
            bf16_t* rowp = X + (size_t)r * 1024 + col0;
            u32x2v w8[2] = {{0u, 0u}, {0u, 0u}};
            f32x2 s2 = {0.f, 0.f};
#pragma unroll
            for (int bj = 0; bj < 2; ++bj) {
                const u32x4 o = xo[g][bj];
                const f32x4 a0 = acc[ai][bj][m][0], a1 = acc[ai][bj][m][1];
                f32x2 p0, p1, p2, p3;
                if (F8) { p0 = (f32x2){a0[0], a0[1]} * asc + (f32x2){bf_lo(o.x), bf_hi(o.x)}; p1 = (f32x2){a0[2], a0[3]} * asc + (f32x2){bf_lo(o.y), bf_hi(o.y)};
                          p2 = (f32x2){a1[0], a1[1]} * asc + (f32x2){bf_lo(o.z), bf_hi(o.z)}; p3 = (f32x2){a1[2], a1[3]} * asc + (f32x2){bf_lo(o.w), bf_hi(o.w)}; }
                else    { p0 = (f32x2){bf_lo(o.x), bf_hi(o.x)} + (f32x2){a0[0], a0[1]}; p1 = (f32x2){bf_lo(o.y), bf_hi(o.y)} + (f32x2){a0[2], a0[3]};
                          p2 = (f32x2){bf_lo(o.z), bf_hi(o.z)} + (f32x2){a1[0], a1[1]}; p3 = (f32x2){bf_lo(o.w), bf_hi(o.w)} + (f32x2){a1[2], a1[3]}; }
                s2 = p0 * p0 + s2; s2 = p1 * p1 + s2; s2 = p2 * p2 + s2; s2 = p3 * p3 + s2;
                u32x4 w; w.x = pk_bf16(p0.x, p0.y); w.y = pk_bf16(p1.x, p1.y); w.z = pk_bf16(p2.x, p2.y); w.w = pk_bf16(p3.x, p3.y);
                *(PG8_GAS u32x4*)(rowp + bj * HALF) = w;
                if (x8) { w8[bj].x = pk4_fp8(p0.x, p0.y, p1.x, p1.y); w8[bj].y = pk4_fp8(p2.x, p2.y, p3.x, p3.y); }
            }
            if (x8) {
                const u32x2v sx = __builtin_amdgcn_permlane16_swap(w8[0].x, w8[1].x, false, false), sy = __builtin_amdgcn_permlane16_swap(w8[0].y, w8[1].y, false, false);
                u32x4 w; w.x = sx[0]; w.y = sy[0]; w.z = sx[1]; w.w = sy[1];
                *(PG8_GAS u32x4*)(x8 + (size_t)r * 1024 + (col0 - 8 * (fq & 1)) + (fq & 1) * HALF) = w;
            }
            sq[g] = s2.x + s2.y;
            if (g + PF < 8) {
                asm volatile("" ::: "memory");
#pragma unroll
                for (int bj = 0; bj < 2; ++bj) xo[g + PF][bj] = *(const PG8_GAS u32x4*)(X + (size_t)(row0 + ((g + PF) >> 2) * HALF + ((g + PF) & 3) * 16) * 1024 + col0 + bj * HALF);
            }
        }
#pragma unroll
        for (int g = 0; g < 8; ++g) sq[g] += __shfl_xor(sq[g], 16);
#pragma unroll
        for (int g = 0; g < 8; ++g) sq[g] += __shfl_xor(sq[g], 32);
#pragma unroll
        for (int g = 0; g < 8; ++g) {
            const int r = row0 + (g >> 2) * HALF + (g & 3) * 16;
            if (fq == 0) (void)__hip_atomic_fetch_add((PG8_GAS unsigned long long*)ssq_out + r, ssq_fix(sq[g]), __ATOMIC_RELAXED, __HIP_MEMORY_SCOPE_AGENT);
        }
    }
};
struct EpiInProj {
    static constexpr bool PERM = true, AFTER_DRAIN = false;
    static constexpr int VMEM_LB = 8;
    bf16_t *Q, *K, *V, *SG, *CU, *GB; const unsigned long long* ssq; size_t adj512, adj1024; const PG8_LAS float* rt; int rbase;
    __device__ __forceinline__ void operator()(const f32x4 (&acc)[2][2][4][2], const Unit& u, int wr, int wc, int fr, int fq) const {
        const int row0 = u.pm * BM + wr * 64 + fr, pn = u.pn, cw = wc * 32 + 8 * fq;
        const size_t a512 = (size_t)(u.pm >> 4) * adj512, a1024 = (size_t)(u.pm >> 4) * adj1024;
        float rsv[2][4]; rows_rstd(ssq, rt, rbase, row0, rsv);
        if (pn >= 6 && pn <= 9) {
#pragma unroll
            for (int ai = 0; ai < 2; ++ai)
#pragma unroll
                for (int m = 0; m < 4; ++m) {
                    const int r = row0 + ai * HALF + m * 16; const float rs = rsv[ai][m], rs2 = rs * rs;
                    float hv[8];
#pragma unroll
                    for (int n = 0; n < 2; ++n)
#pragma unroll
                        for (int j = 0; j < 4; ++j) hv[4 * n + j] = (acc[ai][0][m][n][j] * acc[ai][1][m][n][j]) * rs2;
                    u32x4 w; w.x = pk_bf16(hv[0], hv[1]); w.y = pk_bf16(hv[2], hv[3]); w.z = pk_bf16(hv[4], hv[5]); w.w = pk_bf16(hv[6], hv[7]);
                    *(PG8_GAS u32x4*)(CU + a1024 + (size_t)r * 512 + (pn - 6) * HALF + cw) = w;
                }
        } else {
            bf16_t* base; int ldc, coff; bool act = false;
            if (pn == 0) { base = Q + a512; ldc = 256; coff = 0; }
            else if (pn == 1) { base = K + a512; ldc = 256; coff = 0; }
            else if (pn <= 3) { base = V + a1024; ldc = 512; coff = (pn - 2) * BM; }
            else if (pn <= 5) { base = SG + a1024; ldc = 512; coff = (pn - 4) * BM; act = true; }
            else { base = GB + a1024; ldc = 512; coff = (pn - 10) * BM; }
#pragma unroll
            for (int ai = 0; ai < 2; ++ai)
#pragma unroll
                for (int m = 0; m < 4; ++m) {
                    const int r = row0 + ai * HALF + m * 16; const float rs = rsv[ai][m];
                    bf16_t* rowp = base + (size_t)r * ldc + coff + cw;
#pragma unroll
                    for (int bj = 0; bj < 2; ++bj) {
                        f32x4 a0 = acc[ai][bj][m][0] * rs, a1 = acc[ai][bj][m][1] * rs;
                        if (act) {
#pragma unroll
                            for (int j = 0; j < 4; ++j) { a0[j] = silu_f(a0[j]); a1[j] = silu_f(a1[j]); }
                        }
                        u32x4 w; w.x = pk_bf16(a0[0], a0[1]); w.y = pk_bf16(a0[2], a0[3]); w.z = pk_bf16(a1[0], a1[1]); w.w = pk_bf16(a1[2], a1[3]);
                        *(PG8_GAS u32x4*)(rowp + bj * HALF) = w;
                    }
                }
        }
    }
};
typedef int v4i_t __attribute__((ext_vector_type(4)));
typedef int v8i_t __attribute__((ext_vector_type(8)));
__device__ __forceinline__ v8i_t cat8(bf16x8 lo, bf16x8 hi) { const v4i_t a = __builtin_bit_cast(v4i_t, lo), b = __builtin_bit_cast(v4i_t, hi); return __builtin_shufflevector(a, b, 0, 1, 2, 3, 4, 5, 6, 7); }
template <bool F> struct FragT;
template <> struct FragT<false> { bf16x8 k[2]; };
template <> struct FragT<true> { v8i_t v; };
template <class Epi, class Sched, bool ALIGN_EPI = false, bool SP2 = false, bool FP8 = false>
__device__ __forceinline__ void gemm_phase(PG8_LAS unsigned char* lds, const Gemm g, const Sched& S, const Epi& E) {
    int tid_ = g.wave * 64 + (int)__builtin_amdgcn_mbcnt_hi(~0u, __builtin_amdgcn_mbcnt_lo(~0u, 0u)); asm volatile("" : "+v"(tid_));
    const int tid = tid_, wid = __builtin_amdgcn_readfirstlane(tid >> 6), lane = tid & 63, wr = wid >> 2, wc = wid & 3, fr = lane & 15, fq = lane >> 4;
    const int K = g.K, nt = K / BK;
    unsigned voffA[2], voffB[2];
#pragma unroll
    for (int i = 0; i < 2; ++i) { int R, C; stage_rc(tid * 16 + i * 8192, R, C); const int Rb = Epi::PERM ? ((R & ~31) + perm32(R & 31)) : R;
        voffA[i] = (unsigned)(R * K + C) * 2u; voffB[i] = (unsigned)(Rb * K + C) * 2u; }
    const size_t kstep = (size_t)(BK * 2);
    const size_t hstep = (size_t)(unsigned)(HALF * K * 2);
    const size_t tstep = 2 * hstep;
    const unsigned ldsw = (unsigned)wid * 1024u;
    const int aoff = lds_byte(wr * 64 + fr, fq * 8), boff = lds_byte(wc * 32 + fr, fq * 8);
#define PG8_SA(b, h) (((b) * 2 + (h)) * HTB)
#define PG8_SB(b, h) ((4 + (b) * 2 + (h)) * HTB)
#define PG8_STAGE(bufoff, gbase, voff) do { _Pragma("unroll") for (int _i = 0; _i < 2; ++_i) \
        __builtin_amdgcn_global_load_lds((const unsigned*)((const char*)(gbase) + (voff)[_i]), (PG8_LAS unsigned*)(lds + (bufoff) + ldsw + _i * 8192), 16, 0, 0); } while (0)
#if PG8_DUMMY
#define PG8_DMY() do { _Pragma("unroll") for (int _d = 0; _d < PG8_DUMMY; ++_d) __builtin_amdgcn_global_load_lds((const unsigned*)((const char*)g.Bt + tid * 16), (PG8_LAS unsigned*)(lds + PG8_DUMMY_LDS + ldsw), 16, 0, 0); } while (0)
#define PG8_WAIT_V8() PG8_WAIT_V((8 + 2 * PG8_DUMMY))
#else
#define PG8_DMY() do { } while (0)
#define PG8_WAIT_V8() PG8_WAIT_V(8)
#endif
#if PG8_MMA_PAD
#define PG8_PADM() __builtin_amdgcn_s_sleep(PG8_MMA_PAD)
#else
#define PG8_PADM() do { } while (0)
#endif
#if PG8_LD_PAD
#define PG8_PADL() __builtin_amdgcn_s_sleep(PG8_LD_PAD)
#else
#define PG8_PADL() do { } while (0)
#endif
#define PG8_WAIT_V8F() do { if (t == 0 && ui > 0) PG8_WAIT_V((8 + Epi::VMEM_LB + 2 * PG8_DUMMY)); else PG8_WAIT_V8(); } while (0)
#define PG8_LDF(dst, off_) do { const bf16x8 f0_ = *(const PG8_LAS bf16x8*)(lds + (off_)), f1_ = *(const PG8_LAS bf16x8*)(lds + (off_) + 1024); \
        if constexpr (FP8) { (dst).v = cat8(f0_, f1_); } else { (dst).k[0] = f0_; (dst).k[1] = f1_; } } while (0)
#define PG8_LDA(dst, b, h) do { _Pragma("unroll") for (int m = 0; m < 4; ++m) PG8_LDF(dst[m], PG8_SA(b, h) + aoff + m * 2048); } while (0)
#define PG8_LDB(dst, b, h) do { _Pragma("unroll") for (int n = 0; n < 2; ++n) PG8_LDF(dst[n], PG8_SB(b, h) + boff + n * 2048); } while (0)
#if defined(__HIP_DEVICE_COMPILE__)
#define PG8_F8ASM(ai, bj, At, Bt) asm volatile("s_nop 1\n\t" \
            "v_mfma_scale_f32_16x16x128_f8f6f4 %0, %12, %8, %0, %14, %14 op_sel_hi:[0,0,0]\n\t"  "v_mfma_scale_f32_16x16x128_f8f6f4 %1, %13, %8, %1, %14, %14 op_sel_hi:[0,0,0]\n\t" \
            "v_mfma_scale_f32_16x16x128_f8f6f4 %2, %12, %9, %2, %14, %14 op_sel_hi:[0,0,0]\n\t"  "v_mfma_scale_f32_16x16x128_f8f6f4 %3, %13, %9, %3, %14, %14 op_sel_hi:[0,0,0]\n\t" \
            "v_mfma_scale_f32_16x16x128_f8f6f4 %4, %12, %10, %4, %14, %14 op_sel_hi:[0,0,0]\n\t" "v_mfma_scale_f32_16x16x128_f8f6f4 %5, %13, %10, %5, %14, %14 op_sel_hi:[0,0,0]\n\t" \
            "v_mfma_scale_f32_16x16x128_f8f6f4 %6, %12, %11, %6, %14, %14 op_sel_hi:[0,0,0]\n\t" "v_mfma_scale_f32_16x16x128_f8f6f4 %7, %13, %11, %7, %14, %14 op_sel_hi:[0,0,0]" \
            : "+v"(acc[ai][bj][0][0]), "+v"(acc[ai][bj][0][1]), "+v"(acc[ai][bj][1][0]), "+v"(acc[ai][bj][1][1]), "+v"(acc[ai][bj][2][0]), "+v"(acc[ai][bj][2][1]), "+v"(acc[ai][bj][3][0]), "+v"(acc[ai][bj][3][1]) \
            : "v"(At[0].v), "v"(At[1].v), "v"(At[2].v), "v"(At[3].v), "v"(Bt[0].v), "v"(Bt[1].v), "v"(sc127))
#else
#define PG8_F8ASM(ai, bj, At, Bt) ((void)sc127)
#endif
#if defined(__HIP_DEVICE_COMPILE__)
#define PG8_F8ASMH(ai, bj, At, Bt, m0) asm volatile("s_nop 1\n\t" \
            "v_mfma_scale_f32_16x16x128_f8f6f4 %0, %6, %4, %0, %8, %8 op_sel_hi:[0,0,0]\n\t" "v_mfma_scale_f32_16x16x128_f8f6f4 %1, %7, %4, %1, %8, %8 op_sel_hi:[0,0,0]\n\t" \
            "v_mfma_scale_f32_16x16x128_f8f6f4 %2, %6, %5, %2, %8, %8 op_sel_hi:[0,0,0]\n\t" "v_mfma_scale_f32_16x16x128_f8f6f4 %3, %7, %5, %3, %8, %8 op_sel_hi:[0,0,0]" \
            : "+v"(acc[ai][bj][m0][0]), "+v"(acc[ai][bj][m0][1]), "+v"(acc[ai][bj][m0 + 1][0]), "+v"(acc[ai][bj][m0 + 1][1]) \
            : "v"(At[m0].v), "v"(At[m0 + 1].v), "v"(Bt[0].v), "v"(Bt[1].v), "v"(sc127))
#else
#define PG8_F8ASMH(ai, bj, At, Bt, m0) ((void)sc127)
#endif
#if defined(__HIP_DEVICE_COMPILE__)
#define PG8_F8ASMQ(ai, bj, At, Bt, m_) asm volatile("s_nop 1\n\t" \
            "v_mfma_scale_f32_16x16x128_f8f6f4 %0, %3, %2, %0, %5, %5 op_sel_hi:[0,0,0]\n\t" "v_mfma_scale_f32_16x16x128_f8f6f4 %1, %4, %2, %1, %5, %5 op_sel_hi:[0,0,0]" \
            : "+v"(acc[ai][bj][m_][0]), "+v"(acc[ai][bj][m_][1]) : "v"(At[m_].v), "v"(Bt[0].v), "v"(Bt[1].v), "v"(sc127))
#else
#define PG8_F8ASMQ(ai, bj, At, Bt, m_) ((void)sc127)
#endif
#define PG8_MMA_H(ai, bj, At, Bt) do { __builtin_amdgcn_s_setprio(PG8_PRIO_MMA); \
        if constexpr (FP8) { PG8_F8ASMH(ai, bj, At, Bt, 0); PG8_F8ASMQ(ai, bj, At, Bt, 2); } \
        else { _Pragma("unroll") for (int m = 0; m < 4; ++m) _Pragma("unroll") for (int n = 0; n < 2; ++n) \
            acc[ai][bj][m][n] = __builtin_amdgcn_mfma_f32_16x16x32_bf16(Bt[n].k[0], At[m].k[0], acc[ai][bj][m][n], 0, 0, 0); \
          _Pragma("unroll") for (int m = 0; m < 2; ++m) _Pragma("unroll") for (int n = 0; n < 2; ++n) \
            acc[ai][bj][m][n] = __builtin_amdgcn_mfma_f32_16x16x32_bf16(Bt[n].k[1], At[m].k[1], acc[ai][bj][m][n], 0, 0, 0); } } while (0)
#define PG8_MMA_T(ai, bj, At, Bt) do { \
        if constexpr (FP8) { PG8_F8ASMQ(ai, bj, At, Bt, 3); } \
        else { _Pragma("unroll") for (int m = 2; m < 4; ++m) _Pragma("unroll") for (int n = 0; n < 2; ++n) \
            acc[ai][bj][m][n] = __builtin_amdgcn_mfma_f32_16x16x32_bf16(Bt[n].k[1], At[m].k[1], acc[ai][bj][m][n], 0, 0, 0); } \
        __builtin_amdgcn_s_setprio(PG8_PRIO_LD); } while (0)
#define PG8_MMA_LASTBAR(ai, bj, At, Bt) do { PG8_MMA(ai, bj, At, Bt); if (!(PG8_LATEBB && !ALIGN_EPI && last && wr == 1)) PG8_BAR; } while (0)
#if PG8_EB
#define PG8_MMA_BAR(ai, bj, At, Bt) do { PG8_MMA_H(ai, bj, At, Bt); PG8_SCHED; PG8_BAR; PG8_SCHED; PG8_MMA_T(ai, bj, At, Bt); } while (0)
#else
#define PG8_MMA_BAR(ai, bj, At, Bt) do { PG8_MMA(ai, bj, At, Bt); PG8_PADM(); PG8_BAR; } while (0)
#endif
#define PG8_MMA(ai, bj, At, Bt) do { __builtin_amdgcn_s_setprio(PG8_PRIO_MMA); \
        if constexpr (FP8) { PG8_F8ASM(ai, bj, At, Bt); } \
        else { _Pragma("unroll") for (int m = 0; m < 4; ++m) _Pragma("unroll") for (int n = 0; n < 2; ++n) _Pragma("unroll") for (int k = 0; k < 2; ++k) \
            acc[ai][bj][m][n] = __builtin_amdgcn_mfma_f32_16x16x32_bf16(Bt[n].k[k], At[m].k[k], acc[ai][bj][m][n], 0, 0, 0); } \
        __builtin_amdgcn_s_setprio(PG8_PRIO_LD); } while (0)
#define PG8_WAIT_V(n) do { asm volatile("" ::: "memory"); __builtin_amdgcn_s_waitcnt((((n) & 15) | 0x70 | 0xF00 | (((n) >> 4) << 14))); asm volatile("" ::: "memory"); } while (0)
#define PG8_WAIT_L(n) do { asm volatile("" ::: "memory"); __builtin_amdgcn_s_waitcnt((0xF | 0x70 | ((n) << 8) | (3 << 14))); asm volatile("" ::: "memory"); } while (0)
#define PG8_BAR __builtin_amdgcn_s_barrier()
#define PG8_SCHED __builtin_amdgcn_sched_barrier(0)
    Unit cur, nxt; int ui = 0;
    if (!S.next(0, cur)) return;
    f32x4 acc[2][2][4][2];
#pragma unroll
    for (int a = 0; a < 2; ++a)
#pragma unroll
        for (int b = 0; b < 2; ++b)
#pragma unroll
            for (int m = 0; m < 4; ++m)
#pragma unroll
                for (int n = 0; n < 2; ++n) acc[a][b][m][n] = (f32x4){0.f, 0.f, 0.f, 0.f};
    FragT<FP8> At[4], B0[2], B1[2];
    int sc127 = 127; asm volatile("" : "+v"(sc127));
    const char* cA = (const char*)g.A + (size_t)cur.pm * tstep + (size_t)(cur.pm >> 4) * g.abadj; const char* cB = (const char*)g.Bt + (size_t)cur.pn * tstep;
    S.a_ready(cur);
#if PG8_BAL
    if constexpr (SP2) {
        PG8_STAGE(PG8_SB(0, 0), cB, voffB); PG8_STAGE(PG8_SA(0, 0), cA, voffA); PG8_STAGE(PG8_SB(0, 1), cB + hstep, voffB); PG8_STAGE(PG8_SA(0, 1), cA + hstep, voffA);
        if (wr == 1) PG8_BAR;
        PG8_WAIT_V(0); PG8_BAR;
        PG8_STAGE(PG8_SB(1, 0), cB + kstep, voffB); PG8_STAGE(PG8_SA(1, 0), cA + kstep, voffA);
        PG8_BAR;
    } else
#endif
    if constexpr (SP2) {
        PG8_STAGE(PG8_SB(0, 0), cB, voffB); PG8_STAGE(PG8_SB(0, 1), cB + hstep, voffB); PG8_STAGE(PG8_SA(0, 0), cA, voffA); PG8_STAGE(PG8_SA(0, 1), cA + hstep, voffA);
        if (wr == 1) PG8_BAR;
        PG8_WAIT_V(2); PG8_BAR;
        PG8_STAGE(PG8_SB(1, 0), cB + kstep, voffB); PG8_STAGE(PG8_SA(1, 0), cA + kstep, voffA); PG8_STAGE(PG8_SB(1, 1), cB + hstep + kstep, voffB);
        PG8_WAIT_V(6); PG8_BAR;
    } else {
        PG8_STAGE(PG8_SB(0, 0), cB, voffB); PG8_STAGE(PG8_SA(0, 0), cA, voffA); PG8_STAGE(PG8_SB(0, 1), cB + hstep, voffB); PG8_STAGE(PG8_SA(0, 1), cA + hstep, voffA);
        if (wr == 1) PG8_BAR;
        PG8_WAIT_V(4); PG8_BAR;
        PG8_STAGE(PG8_SB(1, 0), cB + kstep, voffB); PG8_STAGE(PG8_SA(1, 0), cA + kstep, voffA); PG8_STAGE(PG8_SB(1, 1), cB + hstep + kstep, voffB);
        PG8_WAIT_V(6); PG8_BAR;
    }
    for (;;) {
        const bool has_next = S.next(ui + 1, nxt);
        const char* nA = has_next ? (const char*)g.A + (size_t)nxt.pm * tstep + (size_t)(nxt.pm >> 4) * g.abadj : cA; const char* nB = has_next ? (const char*)g.Bt + (size_t)nxt.pn * tstep : cB;
#pragma clang loop unroll(disable)
        for (int t = 0; t < nt; t += 2) {
            const bool last = (t == nt - 2);
            const char* a1 = cA + (size_t)(t + 1) * kstep;
            const char* a2 = last ? nA : cA + (size_t)(t + 2) * kstep; const char* b2 = last ? nB : cB + (size_t)(t + 2) * kstep;
            const char* a3 = a2 + kstep; const char* b3 = b2 + kstep;
            if (last && has_next) S.a_ready(nxt);
#if PG8_BAL
            if constexpr (SP2) {
            const char* b1 = cB + (size_t)(t + 1) * kstep;
            PG8_LDB(B0, 0, 0); PG8_SCHED; PG8_LDA(At, 0, 0); PG8_STAGE(PG8_SB(1, 1), b1 + hstep, voffB); PG8_STAGE(PG8_SA(1, 1), a1 + hstep, voffA);
            PG8_WAIT_V(8); PG8_WAIT_L(0); PG8_BAR; __builtin_amdgcn_s_setprio(1); PG8_LDB(B1, 0, 1); PG8_SCHED; PG8_MMA(0, 0, At, B0); PG8_MMA(0, 1, At, B1); PG8_BAR; PG8_SCHED;
            PG8_LDA(At, 0, 1); PG8_STAGE(PG8_SB(0, 0), b2, voffB); PG8_STAGE(PG8_SA(0, 0), a2, voffA);
            PG8_WAIT_V(8); PG8_WAIT_L(0); PG8_BAR; PG8_MMA(1, 0, At, B0); PG8_MMA(1, 1, At, B1); PG8_WAIT_V(6); PG8_BAR; PG8_SCHED;
            PG8_LDB(B0, 1, 0); PG8_SCHED; PG8_LDA(At, 1, 0); PG8_STAGE(PG8_SB(0, 1), b2 + hstep, voffB); PG8_STAGE(PG8_SA(0, 1), a2 + hstep, voffA);
            PG8_WAIT_V(8); PG8_WAIT_L(0); PG8_BAR; __builtin_amdgcn_s_setprio(1); PG8_LDB(B1, 1, 1); PG8_SCHED; PG8_MMA(0, 0, At, B0); PG8_MMA(0, 1, At, B1); PG8_BAR; PG8_SCHED;
            PG8_LDA(At, 1, 1); PG8_STAGE(PG8_SB(1, 0), b3, voffB); PG8_STAGE(PG8_SA(1, 0), a3, voffA);
            PG8_WAIT_V(8); PG8_WAIT_L(0); PG8_BAR; PG8_MMA(1, 0, At, B0); PG8_MMA(1, 1, At, B1); PG8_WAIT_V(6); PG8_BAR; PG8_SCHED;
            } else
#endif
            if constexpr (SP2) {
            PG8_LDB(B0, 0, 0); PG8_LDB(B1, 0, 1); PG8_SCHED; PG8_LDA(At, 0, 0); PG8_DMY(); PG8_STAGE(PG8_SA(1, 1), a1 + hstep, voffA);
            PG8_WAIT_V8F(); PG8_WAIT_L(0); PG8_PADL(); PG8_BAR; PG8_MMA(0, 0, At, B0); PG8_MMA_BAR(0, 1, At, B1); PG8_SCHED;
            PG8_LDA(At, 0, 1); PG8_DMY(); PG8_STAGE(PG8_SB(0, 0), b2, voffB); PG8_STAGE(PG8_SB(0, 1), b2 + hstep, voffB); PG8_STAGE(PG8_SA(0, 0), a2, voffA);
            PG8_WAIT_V8F(); PG8_WAIT_L(0); PG8_PADL(); PG8_BAR; PG8_MMA(1, 0, At, B0); PG8_MMA_BAR(1, 1, At, B1); PG8_SCHED;
            PG8_LDB(B0, 1, 0); PG8_LDB(B1, 1, 1); PG8_SCHED; PG8_LDA(At, 1, 0); PG8_DMY(); PG8_STAGE(PG8_SA(0, 1), a2 + hstep, voffA);
            PG8_WAIT_V8(); PG8_WAIT_L(0); PG8_PADL(); PG8_BAR; PG8_MMA(0, 0, At, B0); PG8_MMA_BAR(0, 1, At, B1); PG8_SCHED;
            PG8_LDA(At, 1, 1); PG8_DMY(); PG8_STAGE(PG8_SB(1, 0), b3, voffB); PG8_STAGE(PG8_SB(1, 1), b3 + hstep, voffB); PG8_STAGE(PG8_SA(1, 0), a3, voffA);
            PG8_WAIT_V8(); PG8_WAIT_L(0); PG8_PADL(); PG8_BAR; PG8_MMA(1, 0, At, B0); PG8_MMA_LASTBAR(1, 1, At, B1); PG8_SCHED;
            } else {
            PG8_LDB(B0, 0, 0); PG8_SCHED; PG8_LDA(At, 0, 0); PG8_STAGE(PG8_SA(1, 1), a1 + hstep, voffA);
            PG8_WAIT_L(8); PG8_BAR; PG8_WAIT_L(0); PG8_MMA(0, 0, At, B0); PG8_BAR; PG8_SCHED;
            PG8_LDB(B1, 0, 1); PG8_STAGE(PG8_SB(0, 0), b2, voffB);
            PG8_BAR; PG8_WAIT_L(0); PG8_MMA(0, 1, At, B1); PG8_BAR;
            PG8_LDA(At, 0, 1); PG8_STAGE(PG8_SA(0, 0), a2, voffA);
            PG8_BAR; PG8_WAIT_L(0); PG8_MMA(1, 0, At, B0); PG8_BAR; PG8_SCHED;
            PG8_STAGE(PG8_SB(0, 1), b2 + hstep, voffB);
            PG8_WAIT_V(6); PG8_BAR; PG8_MMA(1, 1, At, B1); PG8_BAR;
            PG8_LDB(B0, 1, 0); PG8_SCHED; PG8_LDA(At, 1, 0); PG8_STAGE(PG8_SA(0, 1), a2 + hstep, voffA);
            PG8_WAIT_L(8); PG8_BAR; PG8_WAIT_L(0); PG8_MMA(0, 0, At, B0); PG8_BAR; PG8_SCHED;
            PG8_LDB(B1, 1, 1); PG8_STAGE(PG8_SB(1, 0), b3, voffB);
            PG8_BAR; PG8_WAIT_L(0); PG8_MMA(0, 1, At, B1); PG8_BAR;
            PG8_LDA(At, 1, 1); PG8_STAGE(PG8_SA(1, 0), a3, voffA);
            PG8_BAR; PG8_WAIT_L(0); PG8_MMA(1, 0, At, B0); PG8_BAR; PG8_SCHED;
            PG8_STAGE(PG8_SB(1, 1), b3 + hstep, voffB);
            PG8_WAIT_V(6); PG8_BAR; PG8_MMA(1, 1, At, B1); PG8_BAR;
            }
        }
        if constexpr (FP8) asm volatile("s_nop 15\n\ts_nop 15" ::: "memory");
        if constexpr (ALIGN_EPI) { if (wr == 0) PG8_BAR; }
        if constexpr (!Epi::AFTER_DRAIN) { E(acc, cur, wr, wc, fr, fq); S.done(cur); }
        if constexpr (PG8_LATEBB && !ALIGN_EPI) { if (wr == 1) PG8_BAR; }
        if (!has_next) break;
#pragma unroll
        for (int a = 0; a < 2; ++a)
#pragma unroll
            for (int b = 0; b < 2; ++b)
#pragma unroll
                for (int m = 0; m < 4; ++m)
#pragma unroll
                    for (int n = 0; n < 2; ++n) acc[a][b][m][n] = (f32x4){0.f, 0.f, 0.f, 0.f};
        cur = nxt; cA = nA; cB = nB; ++ui;
        if constexpr (ALIGN_EPI) { if (wr == 1) PG8_BAR; }
    }
    PG8_WAIT_V(0);
    if constexpr (!ALIGN_EPI) { if (wr == 0) PG8_BAR; }
    PG8_BAR;
    if constexpr (Epi::AFTER_DRAIN) { E.fused(acc, cur, wr, wc, fr, fq, lds, wid, lane); S.done(cur); }
#undef PG8_SA
#undef PG8_SB
#undef PG8_STAGE
#undef PG8_PADM
#undef PG8_PADL
#undef PG8_DMY
#undef PG8_WAIT_V8
#undef PG8_WAIT_V8F
#undef PG8_LDF
#undef PG8_LDA
#undef PG8_LDB
#undef PG8_MMA
#undef PG8_MMA_H
#undef PG8_MMA_T
#undef PG8_MMA_BAR
#undef PG8_MMA_LASTBAR
#undef PG8_F8ASMH
#undef PG8_F8ASMQ
#undef PG8_F8ASM
#undef PG8_WAIT_V
#undef PG8_WAIT_L
#undef PG8_BAR
#undef PG8_SCHED
}
}
#define GAS __attribute__((address_space(1)))
#define LAS __attribute__((address_space(3)))
typedef unsigned short bf16;
typedef unsigned v4u __attribute__((ext_vector_type(4)));
typedef float f32x4 __attribute__((ext_vector_type(4)));
typedef short bf16x8 __attribute__((ext_vector_type(8)));
typedef GAS unsigned gu32;
typedef GAS unsigned long long gu64;
#define RLX_AGENT __ATOMIC_RELAXED, __HIP_MEMORY_SCOPE_AGENT
#define LDS_WAIT() asm volatile("s_waitcnt lgkmcnt(0)" ::: "memory")
#define VM_WAIT() asm volatile("s_waitcnt vmcnt(0)" ::: "memory")
__device__ __forceinline__ unsigned long long rt() { return __builtin_amdgcn_s_memrealtime(); }
__device__ __forceinline__ unsigned f2bf(float f) { unsigned u = __builtin_bit_cast(unsigned, f); return (u + 0x7fffu + ((u >> 16) & 1u)) >> 16; }
__device__ __forceinline__ unsigned pk2(float lo, float hi) { return f2bf(lo) | (f2bf(hi) << 16); }

#define XB_TMO      128
#define XB_XCNT(j)  (256  + 64 * (j))
#define XB_XSUB(j)  (1280 + 64 * (j))
#define XB_XGEN(j)  (2304 + 64 * (j))
#define XB_TOP      3328
#define XB_TOPGEN   3392
#define XCD_BAR_WORDS 3456
#define XB_SPIN_CAP (1u << 18)

__device__ __forceinline__ unsigned xb_ld(unsigned* p)              { return __hip_atomic_load(p, __ATOMIC_RELAXED, __HIP_MEMORY_SCOPE_AGENT); }
__device__ __forceinline__ unsigned xb_add(unsigned* p, unsigned v) { return __hip_atomic_fetch_add(p, v, __ATOMIC_RELAXED, __HIP_MEMORY_SCOPE_AGENT); }
__device__ __forceinline__ unsigned xb_xcc_id() { return (unsigned)__builtin_amdgcn_s_getreg((3 << 11) | 20) & 0xFu; }
#define XB_SPIN(cond, bar) do { unsigned _sp = 0; while (cond) { __builtin_amdgcn_s_sleep(1); \
    if ((++_sp & 255u) == 0u) { if (xb_ld(&(bar)[XB_TMO])) break; if (_sp > XB_SPIN_CAP) { atomicAdd(&(bar)[XB_TMO], 1u); break; } } } } while (0)

__device__ __forceinline__ int mk_lane() { return (int)__builtin_amdgcn_mbcnt_hi(~0u, __builtin_amdgcn_mbcnt_lo(~0u, 0u)); }
#define MK_TID(wave_) ((wave_) * 64 + mk_lane())
struct XcdBarrier {
    unsigned* bar; unsigned x;
    int wave;
    volatile LAS unsigned* st;
};

__device__ __forceinline__ XcdBarrier xcd_barrier_post(unsigned* bar, volatile LAS unsigned* st) {
    XcdBarrier b; b.bar = bar; b.x = xb_xcc_id(); b.st = st;
    if (threadIdx.x == 0) (void)xb_add(&bar[XB_XCNT(b.x)], 1u);
    return b;
}
__device__ __forceinline__ void xcd_barrier_complete(unsigned* bar, unsigned x, unsigned& nloc, unsigned& nx) {
    const unsigned G = gridDim.x * gridDim.y * gridDim.z;
    unsigned sum, cnt, mine, sp = 0u;
    for (;;) {
        sum = 0u; cnt = 0u; mine = 0u;
#pragma unroll
        for (unsigned j = 0; j < 16; ++j) { const unsigned c = xb_ld(&bar[XB_XCNT(j)]); sum += c; cnt += (c > 0u) ? 1u : 0u; mine = (j == x) ? c : mine; }
        if (sum == G) break;
        __builtin_amdgcn_s_sleep(1);
        if ((++sp & 255u) == 0u) { if (xb_ld(&bar[XB_TMO])) break; if (sp > XB_SPIN_CAP) { atomicAdd(&bar[XB_TMO], 1u); break; } }
    }
    nloc = mine > 0u ? mine : 1u; nx = cnt > 0u ? cnt : 1u;
}

__device__ __forceinline__ void xcd_barrier(const XcdBarrier& b) {
    asm volatile("s_waitcnt vmcnt(0)" ::: "memory");
    __syncthreads();
    if (b.wave == 0 && mk_lane() == 0) {
        unsigned* bar = b.bar;
        __builtin_amdgcn_s_waitcnt(0);
        unsigned nloc = b.st[0], nx = b.st[1];
        if (nloc == 0u) { xcd_barrier_complete(bar, b.x, nloc, nx); b.st[0] = nloc; b.st[1] = nx; }
        const unsigned old = xb_add(&bar[XB_XSUB(b.x)], 1u);
        const unsigned gen = old / nloc;
        if (old + 1u == (gen + 1u) * nloc) {
            __builtin_amdgcn_fence(__ATOMIC_RELEASE, "agent");
            asm volatile("s_waitcnt vmcnt(0)" ::: "memory");
            const unsigned og = xb_add(&bar[XB_TOP], 1u);
            const unsigned tg = og / nx;
            if (og + 1u == (tg + 1u) * nx) xb_add(&bar[XB_TOPGEN], 1u);
            else XB_SPIN(xb_ld(&bar[XB_TOPGEN]) == tg, bar);
            __builtin_amdgcn_fence(__ATOMIC_ACQUIRE, "agent");
            xb_add(&bar[XB_XGEN(b.x)], 1u);
            asm volatile("s_waitcnt vmcnt(0)" ::: "memory");
        } else {
            XB_SPIN(xb_ld(&bar[XB_XGEN(b.x)]) == gen, bar);
            __builtin_amdgcn_fence(__ATOMIC_ACQUIRE, "agent");
            asm volatile("s_waitcnt vmcnt(0)" ::: "memory");
        }
    }
    __syncthreads();
}


constexpr int D = 1024, BATCH = 8, SEQ = 4096, M = BATCH * SEQ, DEPTH = 4, FF = 2816, NUP = 2 * FF, PROJ = 3088, NIN = 3072;
constexpr int NH = 4, DK = 64, DV = 128, RANK = 16, CHUNK = 64, SEGC = 8  , NSEG = SEQ / (CHUNK * SEGC)  , NUNIT = BATCH * NH * NSEG  ;
constexpr int NSLOT = 2 * DEPTH;
#ifndef FP8_FROM
#define FP8_FROM 3
#endif
#ifndef PROBE_DUP
#define PROBE_DUP 0
#endif
#ifndef DN8_FROM
#define DN8_FROM 3
#endif
static_assert(FP8_FROM >= 1 && FP8_FROM <= 8 && DN8_FROM >= 0 && DN8_FROM <= FP8_FROM, "FP8_FROM / DN8_FROM");
constexpr int NWAVES = 8, NTHR = NWAVES * 64;
enum { I_X = 0, I_F1N, I_F1G, I_F1U, I_F1D, I_MIXN, I_WIN, I_WA2, I_BA, I_GON, I_CONVW, I_WOUT, I_F2N, I_F2G, I_F2U, I_F2D, I_FINN, N_IN };
constexpr size_t MiB = 1u << 20;
constexpr size_t WS_CTL = 0, WS_SSQ = 1 * MiB, CTL_ZERO_BYTES = 5 * MiB;
constexpr size_t WS_WUP = 6 * MiB;
constexpr size_t WS_WDN = 94 * MiB;
constexpr size_t WS_WIN = 138 * MiB;
constexpr size_t WS_WOUT = 164 * MiB;
constexpr size_t WS_XB = 172 * MiB;
constexpr size_t WS_H = 236 * MiB;
constexpr size_t HBB = (size_t)SEQ * FF * 2;
constexpr size_t WS_Q = WS_H, WS_K = WS_H + 2 * MiB, WS_V = WS_H + 4 * MiB, WS_SG = WS_H + 8 * MiB, WS_CU = WS_H + 12 * MiB, WS_GB = WS_H + 16 * MiB, WS_ALR = WS_H + 20 * MiB;
static_assert(20 * MiB + (size_t)SEQ * 32 <= HBB, "per-batch overlay fits inside the batch element's H rows");
__host__ __device__ constexpr size_t badj(int b, int rowbytes) { return (size_t)b * (HBB - (size_t)SEQ * rowbytes); }
constexpr size_t WS_Y = 412 * MiB;
constexpr size_t WS_SEGS = 476 * MiB;
constexpr size_t WS_SEGD = 484 * MiB;
constexpr size_t WS_WA = 485 * MiB;
constexpr size_t WS_END = 486 * MiB;
static_assert(WS_SSQ + (size_t)13 * M * 8 <= CTL_ZERO_BYTES && CTL_ZERO_BYTES <= WS_WUP, "ssq map");
static_assert(WS_H + (size_t)M * FF * 2 <= WS_Y, "d_ws map");
constexpr int CW_TMO = 0;
constexpr int CW_BAR = 4096;
constexpr int CW_GRP = 8192;
constexpr int RING_OFF = 0, RING_BYTES = 131072;
constexpr int LDSCTL_OFF = RING_BYTES, MISC_OFF = LDSCTL_OFF + 320;
constexpr int RST_OFF = LDSCTL_OFF + 1024;
static_assert(PG8_DUMMY_LDS == RST_OFF + 4096 * 4 - RING_OFF, "PG8_DUMMY_LDS");
constexpr int LDS_BYTES = RST_OFF + 4096 * 4 + (PG8_DUMMY ? 8192 : 0);
constexpr int G_O = 0;
constexpr int G_QT = 33792, G_KT = G_QT + 9216, G_KH = G_KT + 9216, G_P = G_KH + 9216;
constexpr int G_VT = G_P + 9216, G_ST = G_VT + 18432;
constexpr int G_ALR = G_ST + 18432, G_W2T = G_ALR + 3072;
constexpr int G_GT = G_W2T + 3072, G_D = G_GT + 2048, G_END = G_D + 256;
static_assert(G_END <= RING_BYTES, "GLA LDS map");

typedef unsigned long long u64;
typedef float f32x16 __attribute__((ext_vector_type(16)));
typedef unsigned v2u __attribute__((ext_vector_type(2)));
using pg8::pk_bf16; using pg8::bf_lo; using pg8::bf_hi; using pg8::RMS_EPS;

struct Frame {
    LAS unsigned char* lds;
    volatile LAS unsigned* MISC;
    gu32* ctl;
    int wave, G, c;
    const float* const* in; float* out; unsigned char* ws;
};

__device__ __forceinline__ float wave_sum(float v) {
#pragma unroll
    for (int o = 1; o < 64; o <<= 1) v += __shfl_xor(v, o);
    return v;
}

__device__ __forceinline__ void fill_rstd(Frame& F, int inst) {
    int tid_ = MK_TID(F.wave); asm volatile("" : "+v"(tid_));
    const u64* ssq = (const u64*)(F.ws + WS_SSQ) + (size_t)inst * M + (size_t)(F.c & 7) * SEQ;
    LAS float* rt = (LAS float*)(F.lds + RST_OFF);
    u64 q[SEQ / NTHR];
#pragma unroll
    for (int i = 0; i < SEQ / NTHR; ++i) q[i] = ssq[tid_ + i * NTHR];
#pragma unroll
    for (int i = 0; i < SEQ / NTHR; ++i) rt[tid_ + i * NTHR] = __builtin_amdgcn_rsqf((float)q[i] * (1.0f / (1024.0f * pg8::SSQ_SCALE)) + RMS_EPS);
    __syncthreads();
}
struct TrP { const float* src; int srcN, k0, scol0, nvalid; bf16* dst; int dstK, drow0; const float* gain; float scale; bool f8; };
__device__ __forceinline__ TrP tr_decode(Frame& F, int it) {
    constexpr int I_UP = (D / 64) * (NUP / 32), I_DN = (FF / 64) * (D / 32), I_IN = (D / 64) * (NIN / 32), I_OUT = (D / 64) * (D / 32);
    constexpr int T_UP = NSLOT * I_UP, T_DN = NSLOT * I_DN, T_IN = DEPTH * I_IN, T_OUT = DEPTH * I_OUT;
    int r = it;
    if (r < T_UP) {
        const int s = r / I_UP; r -= s * I_UP; const int l = s >> 1, w = s & 1;
        const int kb = r / (NUP / 32), db = r % (NUP / 32), t = db >> 3, j = db & 7;
        return TrP{F.in[j < 4 ? (w ? I_F2G : I_F1G) : (w ? I_F2U : I_F1U)] + (size_t)l * D * FF, FF, 64 * kb, 128 * t + 32 * (j & 3), 32, (bf16*)(F.ws + WS_WUP) + (size_t)s * NUP * D, D, 32 * db, F.in[w ? I_F2N : I_F1N] + l * D, s >= FP8_FROM ? pg8::W8_SCALE : 1.0f, s >= FP8_FROM}; }
    r -= T_UP;
    if (r < T_DN) {
        const int s = r / I_DN; r -= s * I_DN; const int l = s >> 1, w = s & 1;
        const int kb = r / (D / 32), db = r % (D / 32);
        return TrP{F.in[w ? I_F2D : I_F1D] + (size_t)l * FF * D, D, 64 * kb, 32 * db, 32, (bf16*)(F.ws + WS_WDN) + (size_t)s * D * FF, FF, 32 * db, nullptr, s >= DN8_FROM ? 0.5f * pg8::W8_SCALE : 0.5f, s >= DN8_FROM}; }
    r -= T_DN;
    if (r < T_IN) {
        const int l = r / I_IN; r -= l * I_IN;
        const int kb = r / (NIN / 32), db = r % (NIN / 32), r0 = 32 * db;
        int col; float scale = 1.0f;
        if (r0 < 1536) { col = r0; if (r0 < 256) scale = 0.125f; }
        else if (r0 < 2560) { const int t = (r0 - 1536) >> 8, w = (r0 - 1536) & 255; col = (w < 128) ? (1552 + 128 * t + w) : (2576 + 128 * t + (w - 128)); }
        else col = 2064 + (r0 - 2560);
        return TrP{F.in[I_WIN] + (size_t)l * D * PROJ, PROJ, 64 * kb, col, 32, (bf16*)(F.ws + WS_WIN) + (size_t)l * NIN * D, D, r0, F.in[I_MIXN] + l * D, scale, false}; }
    r -= T_IN;
    if (r >= T_OUT) {
        r -= T_OUT; const int l = r / (D / 64), kb = r % (D / 64);
        return TrP{F.in[I_WIN] + (size_t)l * D * PROJ, PROJ, 64 * kb, 1536, 16, (bf16*)(F.ws + WS_WA) + (size_t)l * 32 * D, D, 0, F.in[I_MIXN] + l * D, 1.0f, false}; }
    const int l = r / I_OUT; r -= l * I_OUT;
    const int kb = r / (D / 32), db = r % (D / 32);
    return TrP{F.in[I_WOUT] + (size_t)l * D * D, D, 64 * kb, 32 * db, 32, (bf16*)(F.ws + WS_WOUT) + (size_t)l * D * D, D, 32 * db, nullptr, 1.0f, false};
}
__device__ __forceinline__ void tr_load(const TrP& P, int lane, float (&v)[32]) {
    const int n = lane & 31; const float* sp = P.src + (size_t)(P.k0 + (lane >> 5)) * P.srcN + P.scol0 + n;
#pragma unroll
    for (int i = 0; i < 32; ++i) v[i] = (n < P.nvalid) ? sp[(size_t)(2 * i) * P.srcN] : 0.f;
}
__device__ __forceinline__ void tr_finish(const TrP& P, const float (&v)[32], LAS float* scr, int lane) {
    const int n = lane & 31;
#pragma unroll
    for (int i = 0; i < 32; ++i) scr[(2 * i + (lane >> 5)) * 33 + n] = v[i];
    const int c = lane & 7;
    float gv[8];
#pragma unroll
    for (int i = 0; i < 8; ++i) gv[i] = P.gain ? P.gain[P.k0 + 8 * c + i] * P.scale : P.scale;
    LDS_WAIT(); asm volatile("" ::: "memory");
    if (P.f8) {
#pragma unroll
        for (int j = 0; j < 4; ++j) { const int nn = (lane >> 3) + 8 * j; const LAS float* s = scr + (8 * c) * 33 + nn;
            v2u o; o.x = pg8::pk4_fp8(s[0 * 33] * gv[0], s[1 * 33] * gv[1], s[2 * 33] * gv[2], s[3 * 33] * gv[3]); o.y = pg8::pk4_fp8(s[4 * 33] * gv[4], s[5 * 33] * gv[5], s[6 * 33] * gv[6], s[7 * 33] * gv[7]);
            *(GAS v2u*)((unsigned char*)P.dst + (size_t)(P.drow0 + nn) * P.dstK + P.k0 + 8 * c) = o; }
    } else {
#pragma unroll
        for (int j = 0; j < 4; ++j) { const int nn = (lane >> 3) + 8 * j; const LAS float* s = scr + (8 * c) * 33 + nn;
            v4u o; o.x = pk_bf16(s[0 * 33] * gv[0], s[1 * 33] * gv[1]); o.y = pk_bf16(s[2 * 33] * gv[2], s[3 * 33] * gv[3]); o.z = pk_bf16(s[4 * 33] * gv[4], s[5 * 33] * gv[5]); o.w = pk_bf16(s[6 * 33] * gv[6], s[7 * 33] * gv[7]);
            *(GAS v4u*)(P.dst + (size_t)(P.drow0 + nn) * P.dstK + P.k0 + 8 * c) = o; }
    }
    LDS_WAIT(); asm volatile("" ::: "memory");
}
__device__ __forceinline__ void p0_prologue(Frame& F) {
    LAS float* scr = (LAS float*)(F.lds + RING_OFF + F.wave * 16384);
    int tid_ = MK_TID(F.wave); asm volatile("" : "+v"(tid_));
    const int gw = blockIdx.x * NWAVES + F.wave, NGW = F.G * NWAVES, lane = tid_ & 63;
    constexpr int NITEMS = NSLOT * (D / 64) * (NUP / 32) + NSLOT * (FF / 64) * (D / 32) + DEPTH * (D / 64) * (NIN / 32) + DEPTH * (D / 64) * (D / 32) + DEPTH * (D / 64);
    if (gw < NITEMS) {
        TrP pc = tr_decode(F, gw); float vc[32]; tr_load(pc, lane, vc);
        for (int it = gw; it < NITEMS; it += NGW) {
            const int nx = it + NGW; const bool more = nx < NITEMS;
            TrP pn = tr_decode(F, more ? nx : it); float vn[32];
            tr_load(pn, lane, vn);
            tr_finish(pc, vc, scr, lane);
            pc = pn;
#pragma unroll
            for (int i = 0; i < 32; ++i) vc[i] = vn[i];
        }
    }
    u64* ssq0 = (u64*)(F.ws + WS_SSQ);
    for (int m0 = 4 * gw; m0 < M; m0 += 4 * NGW) {
        f32x4 v[4][4];
#pragma unroll
        for (int q = 0; q < 4; ++q) { const GAS f32x4* xr = (const GAS f32x4*)(F.in[I_X] + (size_t)(m0 + q) * D) + lane;
#pragma unroll
            for (int j = 0; j < 4; ++j) v[q][j] = xr[64 * j]; }
#pragma unroll
        for (int q = 0; q < 4; ++q) { GAS v2u* o8 = (GAS v2u*)((bf16*)(F.ws + WS_XB) + (size_t)(m0 + q) * D) + lane; float s = 0.f;
#pragma unroll
            for (int j = 0; j < 4; ++j) { const f32x4 t = v[q][j]; s += (t.x * t.x + t.y * t.y) + (t.z * t.z + t.w * t.w); v2u o; o.x = pk_bf16(t.x, t.y); o.y = pk_bf16(t.z, t.w); o8[64 * j] = o; }
            s = wave_sum(s);
            if (lane == 0) ssq0[m0 + q] = pg8::ssq_fix(s); }
    }
}

__device__ __forceinline__ void final_norm(Frame& F) {
    int tid_ = MK_TID(F.wave); asm volatile("" : "+v"(tid_));
    const int lane = tid_ & 63;
    const u64* ssq = (const u64*)(F.ws + WS_SSQ) + (size_t)12 * M;
    const bf16* xb = (const bf16*)(F.ws + WS_XB);
    const float* gn = F.in[I_FINN];
    for (int uu = F.c; uu < 256; uu += F.G)
    for (int i0 = 0; i0 < 16; i0 += 4) {
        v4u w[4][2]; float rs[4];
#pragma unroll
        for (int q = 0; q < 4; ++q) { const int m = (uu & 7) * SEQ + (uu >> 3) * 128 + F.wave * 16 + i0 + q; rs[q] = pg8::row_rstd(ssq, m);
#pragma unroll
            for (int j = 0; j < 2; ++j) w[q][j] = *(const GAS v4u*)(xb + (size_t)m * D + 8 * lane + 512 * j); }
        f32x4 g[2][2];
#pragma unroll
        for (int j = 0; j < 2; ++j) { g[j][0] = *(const GAS f32x4*)(gn + 8 * lane + 512 * j); g[j][1] = *(const GAS f32x4*)(gn + 8 * lane + 512 * j + 4); }
        asm volatile("" ::: "memory");
#pragma unroll
        for (int q = 0; q < 4; ++q) { const int m = (uu & 7) * SEQ + (uu >> 3) * 128 + F.wave * 16 + i0 + q;
#pragma unroll
            for (int j = 0; j < 2; ++j) {
                const int c = 8 * lane + 512 * j; const v4u ww = w[q][j]; const f32x4 g0 = g[j][0], g1 = g[j][1]; const float r = rs[q];
                f32x4 o0, o1;
                o0.x = bf_lo(ww.x) * r * g0.x; o0.y = bf_hi(ww.x) * r * g0.y; o0.z = bf_lo(ww.y) * r * g0.z; o0.w = bf_hi(ww.y) * r * g0.w;
                o1.x = bf_lo(ww.z) * r * g1.x; o1.y = bf_hi(ww.z) * r * g1.y; o1.z = bf_lo(ww.w) * r * g1.z; o1.w = bf_hi(ww.w) * r * g1.w;
                *(GAS f32x4*)(F.out + (size_t)m * D + c) = o0; *(GAS f32x4*)(F.out + (size_t)m * D + c + 4) = o1;
            } }
    }
}

__device__ __forceinline__ void alr_units(Frame& F, int layer) {
    int tid_ = MK_TID(F.wave); asm volatile("" : "+v"(tid_));
    const int lane = tid_ & 63, w = __builtin_amdgcn_readfirstlane(tid_ >> 6), fr = lane & 15, fq = lane >> 4;
    const bf16* Xb = (const bf16*)(F.ws + WS_XB); const bf16* WA = (const bf16*)(F.ws + WS_WA) + (size_t)layer * 32 * D; bf16* ALRb = (bf16*)(F.ws + WS_ALR);
    const u64* ssq = (const u64*)(F.ws + WS_SSQ) + (size_t)(3 * layer + 1) * M;
    for (int u = F.c; u < M / 128; u += F.G) {
        const int x = u & 7, j = u >> 3;
        const int row0 = (16 * x + (j >> 1)) * 256 + (j & 1) * 128 + 16 * w;
        const bf16* ap = Xb + (size_t)(row0 + fr) * D + 8 * fq; const bf16* bp = WA + (size_t)fr * D + 8 * fq;
        f32x4 acc = {0.f, 0.f, 0.f, 0.f};
#pragma unroll 16
        for (int s = 0; s < D / 32; ++s) {
            const pg8::bf16x8 a = *(const GAS pg8::bf16x8*)(ap + 32 * s), b = *(const GAS pg8::bf16x8*)(bp + 32 * s);
            acc = __builtin_amdgcn_mfma_f32_16x16x32_bf16(a, b, acc, 0, 0, 0);
        }
#pragma unroll
        for (int i = 0; i < 4; ++i) { const int r = row0 + 4 * fq + i; ALRb[badj(x, 32) / 2 + (size_t)r * 16 + fr] = (bf16)(pk_bf16(acc[i] * pg8::row_rstd(ssq, r), 0.f) & 0xffffu); }
    }
}

__device__ __forceinline__ f32x16 mfma32(const LAS unsigned char* aimg, const LAS unsigned char* bimg, f32x16 c) {
    const pg8::bf16x8 a = *(const LAS pg8::bf16x8*)aimg, b = *(const LAS pg8::bf16x8*)bimg;
    return __builtin_amdgcn_mfma_f32_32x32x16_bf16(a, b, c, 0, 0, 0);
}
__device__ __forceinline__ float fexp(float x) { return __builtin_amdgcn_exp2f(x * 1.44269504089f); }
template <bool P2>
__device__ __forceinline__ void gla_pass(Frame& F, int layer) {
    LAS unsigned char* L = F.lds + RING_OFF;
    int tid_ = MK_TID(F.wave); asm volatile("" : "+v"(tid_));
    const int tid = tid_, lane = tid & 63, w = __builtin_amdgcn_readfirstlane(tid >> 6), r = lane & 31, hh = lane >> 5;
    const bf16* Qb0 = (const bf16*)(F.ws + WS_Q); const bf16* Kb0 = (const bf16*)(F.ws + WS_K); const bf16* Vb0 = (const bf16*)(F.ws + WS_V);
    const bf16* SGb0 = (const bf16*)(F.ws + WS_SG); const bf16* ALRb0 = (const bf16*)(F.ws + WS_ALR); bf16* Yb = (bf16*)(F.ws + WS_Y);
    float* SEGS = (float*)(F.ws + WS_SEGS); float* SEGD = (float*)(F.ws + WS_SEGD);
    LAS float* LG = (LAS float*)(L + G_O); LAS float* OS = (LAS float*)(L + G_O);
    LAS bf16* QT = (LAS bf16*)(L + G_QT); LAS bf16* KT = (LAS bf16*)(L + G_KT); LAS bf16* KH = (LAS bf16*)(L + G_KH); LAS bf16* PS = (LAS bf16*)(L + G_P);
    LAS bf16* VT = (LAS bf16*)(L + G_VT); LAS bf16* ST = (LAS bf16*)(L + G_ST); LAS bf16* ALRs = (LAS bf16*)(L + G_ALR); LAS bf16* W2T = (LAS bf16*)(L + G_W2T);
    LAS float* GT = (LAS float*)(L + G_GT); LAS float* DS = (LAS float*)(L + G_D);
    const int kb = w >> 2, vb = w & 3;
    for (int uu = F.c; uu < NUNIT; uu += F.G) {
        const int u = (uu & 7) * 32 + (uu >> 3);
        const int b = u >> 5, h = (u >> 3) & 3, sg = u & 7;
        const int tok0 = b * SEQ + sg * (SEGC * CHUNK);
        const bf16* Qb = Qb0 + badj(b, 512) / 2; const bf16* Kb = Kb0 + badj(b, 512) / 2; const bf16* Vb = Vb0 + badj(b, 1024) / 2; const bf16* SGb = SGb0 + badj(b, 1024) / 2; const bf16* ALRb = ALRb0 + badj(b, 32) / 2;
        __syncthreads();
        { const int dk = tid & 63, rk = tid >> 6; const float* wa = F.in[I_WA2] + (size_t)layer * RANK * 256 + 64 * h + dk;
          W2T[dk * 24 + rk] = (bf16)(pk_bf16(wa[rk * 256], 0.f) & 0xffffu); W2T[dk * 24 + rk + 8] = (bf16)(pk_bf16(wa[(rk + 8) * 256], 0.f) & 0xffffu); }
        f32x16 S;
#pragma unroll
        for (int i = 0; i < 16; ++i) S[i] = 0.f;
        if (P2) {
            const int ub = u - sg;
            for (int sp0 = 0; sp0 < sg; sp0 += 3) {
                float dv[3][16], sv[3][16];
#pragma unroll
                for (int q = 0; q < 3; ++q) {
                    const int sp = (sp0 + q < sg) ? sp0 + q : sg - 1;
                    const float* sd = SEGD + (size_t)(ub + sp) * 64 + 32 * kb; const float* ss = SEGS + ((size_t)(ub + sp) * 64 + 32 * kb) * 128 + 32 * vb + r;
#pragma unroll
                    for (int i = 0; i < 16; ++i) { const int row = (i & 3) + 8 * (i >> 2) + 4 * hh; dv[q][i] = sd[row]; sv[q][i] = ss[(size_t)row * 128]; }
                }
#pragma unroll
                for (int q = 0; q < 3; ++q) { const bool on = (sp0 + q < sg);
#pragma unroll
                    for (int i = 0; i < 16; ++i) S[i] = on ? S[i] * dv[q][i] + sv[q][i] : S[i]; }
            }
#pragma unroll
            for (int i = 0; i < 4; ++i) { v2u o; o.x = pk_bf16(S[4 * i], S[4 * i + 1]); o.y = pk_bf16(S[4 * i + 2], S[4 * i + 3]);
                *(LAS v2u*)(ST + (32 * vb + r) * 72 + 32 * kb + 8 * i + 4 * hh) = o; }
        }
        float dsum = 0.f;
        const float ba = F.in[I_BA][layer * 256 + 64 * h + 32 * (w & 1) + r];
        f32x4 g0 = {0.f, 0.f, 0.f, 0.f}, g1 = g0, g2 = g0, g3 = g0;
        if (P2) { const float* gn = F.in[I_GON] + layer * DV + 16 * (tid & 7); g0 = *(const GAS f32x4*)(gn); g1 = *(const GAS f32x4*)(gn + 4); g2 = *(const GAS f32x4*)(gn + 8); g3 = *(const GAS f32x4*)(gn + 12); }
        v4u nalr = {0u, 0u, 0u, 0u}, nsg0 = {0u, 0u, 0u, 0u}, nsg1 = {0u, 0u, 0u, 0u}; unsigned short nvv[16], nk[8], nq[8];
#define GLA_LOADS(t0_) do { const int tl_ = (t0_); \
            if (tid < 128) nalr = *(const GAS v4u*)(ALRb + (size_t)(tl_ + (tid >> 1)) * 16 + 8 * (tid & 1)); \
            { const bf16* vp_ = Vb + (size_t)(tl_ + 16 * (tid >> 7)) * 512 + 128 * h + (tid & 127); _Pragma("unroll") for (int i = 0; i < 16; ++i) nvv[i] = vp_[(size_t)i * 512]; } \
            { const size_t o_ = (size_t)(tl_ + 8 * (tid >> 6)) * 256 + 64 * h + (tid & 63); _Pragma("unroll") for (int i = 0; i < 8; ++i) { nk[i] = Kb[o_ + (size_t)i * 256]; nq[i] = P2 ? Qb[o_ + (size_t)i * 256] : (unsigned short)0; } } \
            if (P2) { const bf16* sp_ = SGb + (size_t)(tl_ + (tid >> 3)) * 512 + 128 * h + 16 * (tid & 7); nsg0 = *(const GAS v4u*)sp_; nsg1 = *(const GAS v4u*)(sp_ + 8); } } while (0)
        GLA_LOADS(tok0);
        for (int c = 0; c < SEGC; ++c) {
            const int t0 = tok0 + c * CHUNK;
            if (tid < 128) { const int tk = tid >> 1, hf = tid & 1; *(LAS v4u*)(ALRs + tk * 24 + 8 * hf) = nalr; }
            { const int dv = tid & 127, tg = tid >> 7;
              v4u o0, o1; o0.x = nvv[0] | ((unsigned)nvv[1] << 16); o0.y = nvv[2] | ((unsigned)nvv[3] << 16); o0.z = nvv[4] | ((unsigned)nvv[5] << 16); o0.w = nvv[6] | ((unsigned)nvv[7] << 16);
              o1.x = nvv[8] | ((unsigned)nvv[9] << 16); o1.y = nvv[10] | ((unsigned)nvv[11] << 16); o1.z = nvv[12] | ((unsigned)nvv[13] << 16); o1.w = nvv[14] | ((unsigned)nvv[15] << 16);
              *(LAS v4u*)(VT + dv * 72 + 16 * tg) = o0; *(LAS v4u*)(VT + dv * 72 + 16 * tg + 8) = o1; }
            unsigned short qraw[8], kraw[8];
#pragma unroll
            for (int i = 0; i < 8; ++i) { kraw[i] = nk[i]; qraw[i] = nq[i]; }
            const v4u s0 = nsg0, s1 = nsg1;
            { const int tn = t0 + CHUNK < M ? t0 + CHUNK : t0; GLA_LOADS(tn); }
            __syncthreads();
            if (w < 4) {
                const int tb = w >> 1, db = w & 1;
                f32x16 acc;
#pragma unroll
                for (int i = 0; i < 16; ++i) acc[i] = 0.f;
                acc = mfma32((const LAS unsigned char*)(ALRs + (32 * tb + r) * 24 + 8 * hh), (const LAS unsigned char*)(W2T + (32 * db + r) * 24 + 8 * hh), acc);
#pragma unroll
                for (int i = 0; i < 16; ++i) { const int row = (i & 3) + 8 * (i >> 2) + 4 * hh; const float x = acc[i] + ba;
                    const float e = __builtin_amdgcn_exp2f(-1.44269504089f * __builtin_fabsf(x));
                    const float ls = __builtin_fminf(x, 0.f) - 0.69314718056f * __builtin_amdgcn_logf(1.0f + e);
                    LG[(32 * tb + row) * 64 + 32 * db + r] = ls * (1.0f / 16.0f); }
            }
            __syncthreads();
            {
                const int dk = tid & 63, grp = tid >> 6;
                float p[8]; float run = 0.f;
#pragma unroll
                for (int i = 0; i < 8; ++i) { run += LG[(8 * grp + i) * 64 + dk]; p[i] = run; }
                GT[grp * 64 + dk] = run;
                __syncthreads();
                float off = 0.f, blast = 0.f;
#pragma unroll
                for (int g = 0; g < 8; ++g) { const float t = GT[g * 64 + dk]; blast += t; if (g < grp) off += t; }
                unsigned short kh[8];
#pragma unroll
                for (int i = 0; i < 8; ++i) {
                    const float bc = off + p[i]; const float kv = bf_lo((unsigned)kraw[i]);
                    kh[i] = (unsigned short)(pk_bf16(kv * fexp(blast - bc), 0.f) & 0xffffu);
                    if (P2) { const float qv = bf_lo((unsigned)qraw[i]);
                        QT[(8 * grp + i) * 72 + dk] = (bf16)(pk_bf16(qv * fexp(bc), 0.f) & 0xffffu);
                        KT[(8 * grp + i) * 72 + dk] = (bf16)(pk_bf16(kv * fexp(-bc), 0.f) & 0xffffu); }
                }
                v4u o; o.x = kh[0] | ((unsigned)kh[1] << 16); o.y = kh[2] | ((unsigned)kh[3] << 16); o.z = kh[4] | ((unsigned)kh[5] << 16); o.w = kh[6] | ((unsigned)kh[7] << 16);
                *(LAS v4u*)(KH + dk * 72 + 8 * grp) = o;
                if (grp == 0) { DS[dk] = fexp(blast); dsum += blast; }
            }
            __syncthreads();
            if (P2) {
                if (w < 3) {
                    const int tb = (w + 1) >> 1, jb = w >> 1;
                    f32x16 acc;
#pragma unroll
                    for (int i = 0; i < 16; ++i) acc[i] = 0.f;
#pragma unroll
                    for (int s = 0; s < 4; ++s) acc = mfma32((const LAS unsigned char*)(QT + (32 * tb + r) * 72 + 16 * s + 8 * hh), (const LAS unsigned char*)(KT + (32 * jb + r) * 72 + 16 * s + 8 * hh), acc);
#pragma unroll
                    for (int i = 0; i < 16; ++i) { const int tok = 32 * tb + (i & 3) + 8 * (i >> 2) + 4 * hh, tokp = 32 * jb + r;
                        PS[tok * 72 + tokp] = (bf16)(pk_bf16(tokp <= tok ? acc[i] : 0.f, 0.f) & 0xffffu); }
                }
                __syncthreads();
                {
                    const int tb = kb;
                    f32x16 acc;
#pragma unroll
                    for (int i = 0; i < 16; ++i) acc[i] = 0.f;
#pragma unroll
                    for (int s = 0; s < 4; ++s) if (s < 2 || tb) acc = mfma32((const LAS unsigned char*)(PS + (32 * tb + r) * 72 + 16 * s + 8 * hh), (const LAS unsigned char*)(VT + (32 * vb + r) * 72 + 16 * s + 8 * hh), acc);
#pragma unroll
                    for (int s = 0; s < 4; ++s) acc = mfma32((const LAS unsigned char*)(QT + (32 * tb + r) * 72 + 16 * s + 8 * hh), (const LAS unsigned char*)(ST + (32 * vb + r) * 72 + 16 * s + 8 * hh), acc);
#pragma unroll
                    for (int i = 0; i < 16; ++i) OS[(32 * tb + (i & 3) + 8 * (i >> 2) + 4 * hh) * 132 + 32 * vb + r] = acc[i];
                }
                __syncthreads();
                {
                    const int tok = tid >> 3, part = tid & 7;
                    const LAS f32x4* op = (const LAS f32x4*)(OS + tok * 132 + 16 * part);
                    const f32x4 o0 = op[0], o1 = op[1], o2 = op[2], o3 = op[3];
                    float ss = (o0.x * o0.x + o0.y * o0.y) + (o0.z * o0.z + o0.w * o0.w) + (o1.x * o1.x + o1.y * o1.y) + (o1.z * o1.z + o1.w * o1.w)
                             + (o2.x * o2.x + o2.y * o2.y) + (o2.z * o2.z + o2.w * o2.w) + (o3.x * o3.x + o3.y * o3.y) + (o3.z * o3.z + o3.w * o3.w);
                    ss += __shfl_xor(ss, 1); ss += __shfl_xor(ss, 2); ss += __shfl_xor(ss, 4);
                    const float rs = __builtin_amdgcn_rsqf(ss * (1.0f / 128.0f) + RMS_EPS);
                    v4u y0, y1;
                    y0.x = pk_bf16(o0.x * rs * g0.x * bf_lo(s0.x), o0.y * rs * g0.y * bf_hi(s0.x)); y0.y = pk_bf16(o0.z * rs * g0.z * bf_lo(s0.y), o0.w * rs * g0.w * bf_hi(s0.y));
                    y0.z = pk_bf16(o1.x * rs * g1.x * bf_lo(s0.z), o1.y * rs * g1.y * bf_hi(s0.z)); y0.w = pk_bf16(o1.z * rs * g1.z * bf_lo(s0.w), o1.w * rs * g1.w * bf_hi(s0.w));
                    y1.x = pk_bf16(o2.x * rs * g2.x * bf_lo(s1.x), o2.y * rs * g2.y * bf_hi(s1.x)); y1.y = pk_bf16(o2.z * rs * g2.z * bf_lo(s1.y), o2.w * rs * g2.w * bf_hi(s1.y));
                    y1.z = pk_bf16(o3.x * rs * g3.x * bf_lo(s1.z), o3.y * rs * g3.y * bf_hi(s1.z)); y1.w = pk_bf16(o3.z * rs * g3.z * bf_lo(s1.w), o3.w * rs * g3.w * bf_hi(s1.w));
                    bf16* yp = Yb + (size_t)(t0 + tok) * 1024 + 128 * h + 16 * part;
                    *(GAS v4u*)yp = y0; *(GAS v4u*)(yp + 8) = y1;
                }
            }
            {
#pragma unroll
                for (int i = 0; i < 16; ++i) S[i] *= DS[32 * kb + (i & 3) + 8 * (i >> 2) + 4 * hh];
#pragma unroll
                for (int s = 0; s < 4; ++s) S = mfma32((const LAS unsigned char*)(KH + (32 * kb + r) * 72 + 16 * s + 8 * hh), (const LAS unsigned char*)(VT + (32 * vb + r) * 72 + 16 * s + 8 * hh), S);
                if (P2) {
#pragma unroll
                    for (int i = 0; i < 4; ++i) { v2u o; o.x = pk_bf16(S[4 * i], S[4 * i + 1]); o.y = pk_bf16(S[4 * i + 2], S[4 * i + 3]);
                        *(LAS v2u*)(ST + (32 * vb + r) * 72 + 32 * kb + 8 * i + 4 * hh) = o; }
                }
            }
            __syncthreads();
        }
#undef GLA_LOADS
        if (!P2) {
#pragma unroll
            for (int i = 0; i < 16; ++i) SEGS[((size_t)u * 64 + 32 * kb + (i & 3) + 8 * (i >> 2) + 4 * hh) * 128 + 32 * vb + r] = S[i];
            if (tid < 64) SEGD[(size_t)u * 64 + tid] = fexp(dsum);
        }
    }
    if (!P2) {
        const int cg = tid & 63;
        float wv[3][8];
#pragma unroll
        for (int j = 0; j < 3; ++j)
#pragma unroll
            for (int e = 0; e < 8; ++e) wv[j][e] = F.in[I_CONVW][(size_t)layer * 3 * 512 + j * 512 + 8 * cg + e];
        for (int uu = F.c; uu < 256; uu += F.G) {
        const int cb = uu & 7;
        const bf16* CUb = (const bf16*)(F.ws + WS_CU) + badj(cb, 1024) / 2; const bf16* GBb = (const bf16*)(F.ws + WS_GB) + badj(cb, 1024) / 2;
        for (int k0 = 0; k0 < SEQ / 256; k0 += 4) {
            v4u c2[4], c1[4], c0[4], gb[4];
            const v4u zero = {0u, 0u, 0u, 0u};
#pragma unroll
            for (int q = 0; q < 4; ++q) {
                const int t = cb * SEQ + 256 * (k0 + q) + 8 * (uu >> 3) + (tid >> 6), pos = t & (SEQ - 1);
                c2[q] = *(const GAS v4u*)(CUb + (size_t)t * 512 + 8 * cg);
                c1[q] = pos >= 1 ? *(const GAS v4u*)(CUb + (size_t)(t - 1) * 512 + 8 * cg) : zero;
                c0[q] = pos >= 2 ? *(const GAS v4u*)(CUb + (size_t)(t - 2) * 512 + 8 * cg) : zero;
                gb[q] = *(const GAS v4u*)(GBb + (size_t)t * 512 + 8 * cg);
            }
            asm volatile("" ::: "memory");
#pragma unroll
            for (int q = 0; q < 4; ++q) {
                const int t = cb * SEQ + 256 * (k0 + q) + 8 * (uu >> 3) + (tid >> 6);
                float z[8];
#pragma unroll
                for (int e = 0; e < 4; ++e) {
                    z[2 * e]     = bf_lo(gb[q][e]) * (wv[0][2 * e] * bf_lo(c0[q][e]) + wv[1][2 * e] * bf_lo(c1[q][e]) + wv[2][2 * e] * bf_lo(c2[q][e]));
                    z[2 * e + 1] = bf_hi(gb[q][e]) * (wv[0][2 * e + 1] * bf_hi(c0[q][e]) + wv[1][2 * e + 1] * bf_hi(c1[q][e]) + wv[2][2 * e + 1] * bf_hi(c2[q][e]));
                }
                v4u o; o.x = pk_bf16(z[0], z[1]); o.y = pk_bf16(z[2], z[3]); o.z = pk_bf16(z[4], z[5]); o.w = pk_bf16(z[6], z[7]);
                *(GAS v4u*)(Yb + (size_t)t * 1024 + 512 + 8 * cg) = o;
            }
        }
        }
    }
}

__device__ __forceinline__ void grp_barrier(unsigned* cnt, unsigned* bar, int wave) {
    asm volatile("s_waitcnt vmcnt(0)" ::: "memory");
    __syncthreads();
    if (wave == 0 && mk_lane() == 0) {
        __builtin_amdgcn_s_waitcnt(0);
        const unsigned old = xb_add(cnt, 1u);
        const unsigned target = (old / 32u + 1u) * 32u;
        XB_SPIN(xb_ld(cnt) < target, bar);
        __builtin_amdgcn_fence(__ATOMIC_ACQUIRE, "agent");
        asm volatile("s_waitcnt vmcnt(0)" ::: "memory");
    }
    __syncthreads();
}
#ifndef LOCAL_SYNC
#define LOCAL_SYNC 1
#endif
constexpr size_t X8H_OFF = 12 * MiB, X8H_ADJ = HBB - (size_t)SEQ * 1024, X8Y_ADJ = (size_t)SEQ * 1024;
static_assert(X8H_OFF >= (size_t)SEQ * FF && X8H_OFF + (size_t)SEQ * 1024 <= HBB, "fp8 residual copy fits beside the fp8 hidden rows of its batch element");
#define IN(k) (lo <= (k) && (k) < hi)
#define SEAM(k) do { if (IN(k) && IN((k) + 1)) { XcdBarrier b2_ = bar; asm volatile("" : "+s"(b2_.bar)); unsigned* g2_ = gcnt; asm volatile("" : "+s"(g2_)); if (lmode) grp_barrier(g2_, b2_.bar, F.wave); else xcd_barrier(b2_); } } while (0)
__device__ __forceinline__ int opq(int v) { asm volatile("" : "+s"(v)); return v; }
template <bool F8, bool DN8>
__device__ __forceinline__ void run_slots(Frame& F, const XcdBarrier& bar, const bool lmode, unsigned* gcnt, const int lo, const int hi, int& p, const int s0, const int s1) {
#define RTAB_DECL const bool tab = (opq(F.G) == 256); const LAS float* rtab = tab ? (const LAS float*)(F.lds + RST_OFF) : nullptr; const int rbase = (opq(F.c) & 7) * SEQ
    for (int s = s0; s < s1; ++s) {
        const int layer = s >> 1, ninst = 3 * layer + ((s & 1) ? 2 : 0);
        if (IN(p)) {
            unsigned char* ws = F.ws; asm volatile("" : "+s"(ws));
            bf16* XB = (bf16*)(ws + WS_XB); unsigned char* HBy = ws + WS_H; u64* SSQ = (u64*)(ws + WS_SSQ);
            const bf16* A = F8 ? ((s & 1) ? (const bf16*)(ws + WS_H + X8H_OFF) : (const bf16*)(ws + WS_Y)) : XB;
            pg8::Gemm g{A, (const bf16*)(ws + WS_WUP) + (size_t)s * NUP * D, M, NUP, F8 ? D / 2 : D, F8 ? ((s & 1) ? X8H_ADJ : X8Y_ADJ) : (size_t)0, F.wave}; pg8::StaticOrder S; S.init(M, NUP, F.G, opq(F.c));
            RTAB_DECL;
            if (tab) fill_rstd(F, ninst);
            pg8::EpiSwiGLUT<F8, DN8> E{HBy, SSQ + (size_t)ninst * M, DN8 ? FF : 2 * FF, DN8 ? HBB / 2 : (size_t)0, rtab, rbase};
            pg8::gemm_phase<pg8::EpiSwiGLUT<F8, DN8>, pg8::StaticOrder, PG8_ALIGN, PG8_SP2, F8>(F.lds + RING_OFF, g, S, E);
        }
        SEAM(p); ++p;
        if (IN(p)) {
            unsigned char* ws = F.ws; asm volatile("" : "+s"(ws));
            bf16* XB = (bf16*)(ws + WS_XB); unsigned char* HBy = ws + WS_H; u64* SSQ = (u64*)(ws + WS_SSQ);
            pg8::Gemm g{(const bf16*)HBy, (const bf16*)(ws + WS_WDN) + (size_t)s * D * FF, M, D, DN8 ? FF / 2 : FF, DN8 ? HBB / 2 : (size_t)0, F.wave}; pg8::StaticOrder S; S.init(M, D, F.G, opq(F.c));
            const bool nx8 = (s & 1) && (s + 1 >= FP8_FROM) && (s + 1 < NSLOT);
            pg8::EpiResidualT<DN8> E{XB, SSQ + (size_t)(ninst + 1) * M, nx8 ? ws + WS_Y : nullptr, X8Y_ADJ};
            pg8::gemm_phase<pg8::EpiResidualT<DN8>, pg8::StaticOrder, PG8_ALIGN, PG8_SP2, DN8>(F.lds + RING_OFF, g, S, E);
        }
        SEAM(p); ++p;
        if (!(s & 1)) {
            if (IN(p)) {
                unsigned char* ws = F.ws; asm volatile("" : "+s"(ws));
                bf16* XB = (bf16*)(ws + WS_XB); u64* SSQ = (u64*)(ws + WS_SSQ);
                pg8::Gemm g{XB, (const bf16*)(ws + WS_WIN) + (size_t)layer * NIN * D, M, NIN, D, 0, F.wave}; pg8::StaticOrder S; S.init(M, NIN, F.G, opq(F.c));
                RTAB_DECL;
                if (tab) fill_rstd(F, 3 * layer + 1);
                pg8::EpiInProj E{(bf16*)(ws + WS_Q), (bf16*)(ws + WS_K), (bf16*)(ws + WS_V), (bf16*)(ws + WS_SG), (bf16*)(ws + WS_CU), (bf16*)(ws + WS_GB), SSQ + (size_t)(3 * layer + 1) * M, badj(1, 512) / 2, badj(1, 1024) / 2, rtab, rbase};
                pg8::gemm_phase<pg8::EpiInProj, pg8::StaticOrder, PG8_ALIGN, PG8_SP2, false>(F.lds + RING_OFF, g, S, E);
                alr_units(F, layer);
            }
            SEAM(p); ++p;
            if (IN(p)) { gla_pass<false>(F, layer); if (PROBE_DUP & 1) gla_pass<false>(F, layer); }
            SEAM(p); ++p;
            if (IN(p)) { gla_pass<true>(F, layer); if (PROBE_DUP & 2) gla_pass<true>(F, layer); }
            SEAM(p); ++p;
            if (IN(p)) {
                unsigned char* ws = F.ws; asm volatile("" : "+s"(ws));
                bf16* XB = (bf16*)(ws + WS_XB); bf16* YB = (bf16*)(ws + WS_Y); u64* SSQ = (u64*)(ws + WS_SSQ);
                pg8::Gemm g{YB, (const bf16*)(ws + WS_WOUT) + (size_t)layer * D * D, M, D, D, 0, F.wave}; pg8::StaticOrder S; S.init(M, D, F.G, opq(F.c));
                const bool nx8 = (s + 1 >= FP8_FROM);
                pg8::EpiResidualT<false> E{XB, SSQ + (size_t)(3 * layer + 2) * M, nx8 ? ws + WS_H + X8H_OFF : nullptr, X8H_ADJ};
                pg8::gemm_phase<pg8::EpiResidualT<false>, pg8::StaticOrder, PG8_ALIGN, PG8_SP2, false>(F.lds + RING_OFF, g, S, E);
            }
            SEAM(p); ++p;
        }
    }
}
#ifndef MK_N_LAUNCHES
#define MK_N_LAUNCHES 1
#endif
constexpr int N_PHASES = 1 + NSLOT * 2 + DEPTH * 4 + 1;
struct Args { const float* in[N_IN]; float* out; unsigned char* ws; int ph_lo, ph_hi; };
static_assert(sizeof(Args) == (N_IN + 2) * 8 + 8, "Args has no padding");
__global__ void __launch_bounds__(NTHR, 2) mk_fwd(Args args) {
    extern __shared__ __attribute__((aligned(16))) unsigned char lds[];
    Frame F;
    F.lds = (LAS unsigned char*)lds;
    F.MISC = (volatile LAS unsigned*)(F.lds + MISC_OFF);
    F.wave = __builtin_amdgcn_readfirstlane((int)threadIdx.x >> 6);
    F.G = gridDim.x;
    F.ws = args.ws; F.out = args.out; F.ctl = (gu32*)(args.ws + WS_CTL);
    F.in = args.in;
    for (int u = threadIdx.x; u < (LDS_BYTES - LDSCTL_OFF) / 4; u += NTHR) ((LAS unsigned*)(F.lds + LDSCTL_OFF))[u] = 0u;
    __syncthreads();
    const int lo = args.ph_lo, hi = args.ph_hi;
    const bool one_launch = (hi - lo) > 1;
    XcdBarrier bar; bar.bar = (unsigned*)(F.ctl + CW_BAR); bar.x = 0; bar.st = nullptr; bar.wave = F.wave;
    if (one_launch) {
        bar.x = xb_xcc_id(); bar.st = F.MISC + 8;
        if (threadIdx.x == 0) F.MISC[10] = xb_add(&bar.bar[XB_XCNT(bar.x)], 1u);
    }
    F.c = (int)blockIdx.x;
    bool lmode = false; unsigned* gcnt = (unsigned*)(F.ctl + CW_GRP);
    int p = 0;
    if (IN(p)) p0_prologue(F);
    SEAM(p); ++p;
    if (one_launch && LOCAL_SYNC) {
        if (threadIdx.x == 0) {
            unsigned ok = (gridDim.x == 256u) ? 1u : 0u, rank = 0u, npop = 0u;
            for (unsigned j = 0; j < 16; ++j) { const unsigned cn = xb_ld(&bar.bar[XB_XCNT(j)]); if (cn) { ++npop; if (cn != 32u) ok = 0u; if (j < bar.x) ++rank; } }
            if (npop != 8u) ok = 0u;
#if defined(FORCE_FALLBACK)
            ok = 0u;
#endif
            F.MISC[11] = ok; F.MISC[12] = rank;
        }
        __syncthreads();
        if (__builtin_amdgcn_readfirstlane((int)F.MISC[11]) != 0) {
            const int grp = __builtin_amdgcn_readfirstlane((int)F.MISC[12]);
            lmode = true; gcnt += 64 * grp;
            F.c = __builtin_amdgcn_readfirstlane(grp + 8 * (int)F.MISC[10]);
        }
    }
    run_slots<false, false>(F, bar, lmode, gcnt, lo, hi, p, 0, DN8_FROM);
    if constexpr (DN8_FROM < FP8_FROM) run_slots<false, true>(F, bar, lmode, gcnt, lo, hi, p, DN8_FROM, FP8_FROM);
    run_slots<true, true>(F, bar, lmode, gcnt, lo, hi, p, FP8_FROM, NSLOT);
    if (IN(p)) final_norm(F);
#undef IN
#undef SEAM
}

extern "C" void kernel_launch(void* const* d_in, const int* in_sizes, int n_in, void* d_out, int out_size, void* d_ws, size_t ws_size, hipStream_t stream) {
    static int grid = 0;
    if (grid == 0) {
        if (n_in != N_IN || in_sizes[0] != M * D || out_size != M * D || ws_size < WS_END) {
            fprintf(stderr, "kernel_launch: built for %d inputs, x/out of %d floats, >= %zu bytes of workspace; got n_in %d, in0 %d, out %d, ws %zu; nothing launched\n", N_IN, M * D, (size_t)WS_END, n_in, n_in > 0 ? in_sizes[0] : -1, out_size, ws_size);
            grid = -1; return; }
        int dev = 0, cus = 0, per_cu = 0;
        if (hipGetDevice(&dev) != hipSuccess || hipDeviceGetAttribute(&cus, hipDeviceAttributeMultiprocessorCount, dev) != hipSuccess) { fprintf(stderr, "kernel_launch: device query failed\n"); grid = -1; return; }
        if (hipFuncSetAttribute((const void*)mk_fwd, hipFuncAttributeMaxDynamicSharedMemorySize, LDS_BYTES) != hipSuccess) { fprintf(stderr, "kernel_launch: hipFuncSetAttribute failed\n"); grid = -1; return; }
        if (hipOccupancyMaxActiveBlocksPerMultiprocessor(&per_cu, (const void*)mk_fwd, NTHR, LDS_BYTES) != hipSuccess || per_cu < 1)
            fprintf(stderr, "kernel_launch: note: occupancy query reports %d workgroups per CU\n", per_cu);
        (void)hipGetLastError();
        grid = cus;
    }
    if (grid < 0) return;
    if (hipMemsetAsync((char*)d_ws + WS_CTL, 0, CTL_ZERO_BYTES, stream) != hipSuccess) { fprintf(stderr, "kernel_launch: hipMemsetAsync failed\n"); return; }
    Args a{};
    for (int i = 0; i < N_IN; ++i) a.in[i] = (const float*)d_in[i];
    a.out = (float*)d_out; a.ws = (unsigned char*)d_ws;
#if MK_N_LAUNCHES == 1
    a.ph_lo = 0; a.ph_hi = N_PHASES;
    hipLaunchKernelGGL(mk_fwd, dim3(grid), dim3(NTHR), LDS_BYTES, stream, a);
#else
    for (int li = 0; li < N_PHASES; ++li) { a.ph_lo = li; a.ph_hi = li + 1; hipLaunchKernelGGL(mk_fwd, dim3(grid), dim3(NTHR), LDS_BYTES, stream, a); }
#endif
    const hipError_t le = hipPeekAtLastError();
    if (le != hipSuccess) fprintf(stderr, "kernel_launch: launch failed: %s\n", hipGetErrorName(le));
}
```
